# Optimizing an MI355X kernel written in HIP

```python
import math
import jax, jax.numpy as jnp
from jax import lax
import numpy as np

D_MODEL = 1024
BATCH = 32
SEQ = 2048
DEPTH = 1

PLE_DIM = 256
CONV_WIDTH = 1024
CONV_K = 3
N_HEADS = 8
HEAD_DIM = 64
V_DIM = 2 * HEAD_DIM
ATTN_WIDTH = N_HEADS * V_DIM
QK_WIDTH = N_HEADS * 2 * HEAD_DIM
Q_BLOCK = 128
LN_EPS = 1e-5
RMS_EPS = 1e-5

BRANCH_COLS = (CONV_WIDTH, CONV_WIDTH, CONV_WIDTH, CONV_WIDTH,
               QK_WIDTH, QK_WIDTH, ATTN_WIDTH, ATTN_WIDTH,
               D_MODEL, D_MODEL)
TOTAL_COLS = sum(BRANCH_COLS)
SPLIT_POINTS = tuple(int(s) for s in np.cumsum(BRANCH_COLS)[:-1])

kernel_name = "hybrid_shortconv_diffattn_deepnorm_encoder"


def alibi_slopes():
    return jnp.asarray(np.float32(2.0) ** (-8.0 * np.arange(1, N_HEADS + 1, dtype=np.float32) / N_HEADS))


def layer_norm(x, g, b):
    xf = x.astype(jnp.float32)
    mu = jnp.mean(xf, axis=-1, keepdims=True)
    xc = xf - mu
    var = jnp.mean(xc * xc, axis=-1, keepdims=True)
    y = xc * lax.rsqrt(var + LN_EPS) * g.astype(jnp.float32) + b.astype(jnp.float32)
    return y.astype(x.dtype)


def rms_norm(x, g):
    xf = x.astype(jnp.float32)
    y = xf * lax.rsqrt(jnp.mean(xf * xf, axis=-1, keepdims=True) + RMS_EPS) * g.astype(jnp.float32)
    return y.astype(x.dtype)


def short_conv_branch(u, c, bgate, z, conv_w, conv_b, w_proj):
    h = c * u
    h = lax.conv_general_dilated(
        h, conv_w[:, None, :], window_strides=(1,),
        padding=[(CONV_K // 2, CONV_K // 2)],
        dimension_numbers=("NWC", "WIO", "NWC"),
        feature_group_count=CONV_WIDTH) + conv_b
    y = bgate * h * jax.nn.silu(z)
    return y @ w_proj


def diff_attention_branch(q, k, v, z, lq1, lk1, lq2, lk2, subln_g, w_proj, slopes, lambda_init):
    bsz, seq, _ = q.shape
    q = q.reshape(bsz, seq, N_HEADS, 2, HEAD_DIM) * (HEAD_DIM ** -0.5)
    k = k.reshape(bsz, seq, N_HEADS, 2, HEAD_DIM)
    v = v.reshape(bsz, seq, N_HEADS, V_DIM)
    lam = (jnp.exp(jnp.sum(lq1.astype(jnp.float32) * lk1.astype(jnp.float32)))
           - jnp.exp(jnp.sum(lq2.astype(jnp.float32) * lk2.astype(jnp.float32)))
           + lambda_init)
    n_blocks = seq // Q_BLOCK
    q_blocks = q.reshape(bsz, n_blocks, Q_BLOCK, N_HEADS, 2, HEAD_DIM).transpose(1, 0, 2, 3, 4, 5)
    q_pos = jnp.arange(seq, dtype=jnp.int32).reshape(n_blocks, Q_BLOCK)
    k_pos = jnp.arange(seq, dtype=jnp.int32)

    def attend(args):
        qb, qp = args
        logits = jnp.einsum("bqhmd,bkhmd->bhmqk", qb, k).astype(jnp.float32)
        dist = jnp.abs(qp[:, None] - k_pos[None, :]).astype(jnp.float32)
        logits = logits - slopes[:, None, None, None] * dist
        probs = jax.nn.softmax(logits, axis=-1)
        weights = probs[:, :, 0] - lam * probs[:, :, 1]
        return jnp.einsum("bhqk,bkhe->bqhe", weights.astype(v.dtype), v)

    o = lax.map(attend, (q_blocks, q_pos))
    o = o.transpose(1, 0, 2, 3, 4).reshape(bsz, seq, N_HEADS, V_DIM)
    o = rms_norm(o, subln_g) * (1.0 - lambda_init)
    o = o.reshape(bsz, seq, ATTN_WIDTH) * jax.nn.silu(z)
    return o @ w_proj


def setup_inputs(seed: int = 0) -> dict:
    key = jax.random.key(seed)
    ks = jax.random.split(key, 17)
    beta = (8.0 * DEPTH) ** -0.25
    f32 = jnp.float32
    col_scale = jnp.concatenate([
        jnp.full((n,), s, dtype=f32) for n, s in zip(
            BRANCH_COLS, (beta, 1.0, 1.0, 1.0, 1.0, 1.0, beta, 1.0, 1.0, 1.0))])
    x = jax.random.normal(ks[0], (BATCH, SEQ, D_MODEL), f32)
    p = jax.random.normal(ks[1], (DEPTH, BATCH, SEQ, PLE_DIM), f32)
    w_in = jax.random.normal(ks[2], (DEPTH, D_MODEL, TOTAL_COLS), f32) * (D_MODEL ** -0.5) * col_scale
    conv_w = jax.random.normal(ks[3], (DEPTH, CONV_K, CONV_WIDTH), f32) * (CONV_K ** -0.5)
    conv_b = 0.01 * jax.random.normal(ks[4], (DEPTH, CONV_WIDTH), f32)
    w_proj_a = jax.random.normal(ks[5], (DEPTH, CONV_WIDTH, D_MODEL), f32) * (CONV_WIDTH ** -0.5) * beta
    lambda_q1 = 0.1 * jax.random.normal(ks[6], (DEPTH, HEAD_DIM), f32)
    lambda_k1 = 0.1 * jax.random.normal(ks[7], (DEPTH, HEAD_DIM), f32)
    lambda_q2 = 0.1 * jax.random.normal(ks[8], (DEPTH, HEAD_DIM), f32)
    lambda_k2 = 0.1 * jax.random.normal(ks[9], (DEPTH, HEAD_DIM), f32)
    subln_g = 1.0 + 0.01 * jax.random.normal(ks[10], (DEPTH, V_DIM), f32)
    w_proj_b = jax.random.normal(ks[11], (DEPTH, ATTN_WIDTH, D_MODEL), f32) * (ATTN_WIDTH ** -0.5) * beta
    w_out = jax.random.normal(ks[12], (DEPTH, D_MODEL, D_MODEL), f32) * (D_MODEL ** -0.5) * beta
    w_ple = jax.random.normal(ks[13], (DEPTH, PLE_DIM, D_MODEL), f32) * (PLE_DIM ** -0.5)
    w_ple_gate = jax.random.normal(ks[14], (DEPTH, D_MODEL, D_MODEL), f32) * (D_MODEL ** -0.5)
    ln_g = 1.0 + 0.01 * jax.random.normal(ks[15], (DEPTH, D_MODEL), f32)
    ln_b = 0.01 * jax.random.normal(ks[16], (DEPTH, D_MODEL), f32)
    return {"x": x, "p": p, "w_in": w_in, "conv_w": conv_w, "conv_b": conv_b,
            "w_proj_a": w_proj_a, "lambda_q1": lambda_q1, "lambda_k1": lambda_k1,
            "lambda_q2": lambda_q2, "lambda_k2": lambda_k2, "subln_g": subln_g,
            "w_proj_b": w_proj_b, "w_out": w_out, "w_ple": w_ple,
            "w_ple_gate": w_ple_gate, "ln_g": ln_g, "ln_b": ln_b}


def reference(x, p, w_in, conv_w, conv_b, w_proj_a, lambda_q1, lambda_k1, lambda_q2,
              lambda_k2, subln_g, w_proj_b, w_out, w_ple, w_ple_gate, ln_g, ln_b):
    alpha = (2.0 * DEPTH) ** 0.25
    slopes = alibi_slopes()
    h = x
    for i in range(DEPTH):
        lambda_init = 0.8 - 0.6 * math.exp(-0.3 * i)
        proj = h @ w_in[i]
        u, c, bg, za, q, k, v, zb, ga, gb = jnp.split(proj, SPLIT_POINTS, axis=-1)
        y_a = short_conv_branch(u, c, bg, za, conv_w[i], conv_b[i], w_proj_a[i])
        y_b = diff_attention_branch(q, k, v, zb, lambda_q1[i], lambda_k1[i], lambda_q2[i],
                                    lambda_k2[i], subln_g[i], w_proj_b[i], slopes, lambda_init)
        merged = jax.nn.sigmoid(ga) * y_a + jax.nn.sigmoid(gb) * y_b
        r = alpha * h + merged @ w_out[i]
        r = r + jax.nn.sigmoid(r @ w_ple_gate[i]) * (p[i] @ w_ple[i])
        h = layer_norm(r, ln_g[i], ln_b[i])
    return h
```

```cpp
#include <hip/hip_runtime.h>
#include <cstdio>
#include <cstdint>
__device__ __forceinline__ int fresh_tid(int wave_s) { int l; asm volatile("v_mbcnt_lo_u32_b32 %0, -1, 0\n\tv_mbcnt_hi_u32_b32 %0, -1, %0" : "=v"(l)); return wave_s * 64 + l; }
namespace pg8 {
#define PG8_LAS __attribute__((address_space(3)))
typedef unsigned short bf16_t;
typedef short bf16x8 __attribute__((ext_vector_type(8)));
typedef float f32x4 __attribute__((ext_vector_type(4)));
typedef unsigned u32x4 __attribute__((ext_vector_type(4)));
constexpr int BM = 256, BK = 64, HALF = 128, HTB = HALF * BK * 2  , STAGE_BYTES = 8 * HTB, NXCD = 8, WGM = 8;

__host__ __device__ __forceinline__ int lds_byte(int r, int c) { const int st = (r >> 4) * 2 + (c >> 5), rr = r & 15, cc = c & 31, ob = rr * 64 + cc * 2; return st * 1024 + (ob ^ (((ob >> 9) & 1) << 5)); }
__host__ __device__ __forceinline__ void stage_rc(int b, int& R, int& C) { const int st = b / 1024, sb = b % 1024, swz = sb ^ (((sb >> 9) & 1) << 5); R = (st >> 1) * 16 + swz / 64; C = (st & 1) * 32 + (swz % 64) / 2; }
__host__ __device__ __forceinline__ int perm32(int rho) { const int n = rho >> 4, i = rho & 15; return 8 * (i >> 2) + 4 * n + (i & 3); }

struct Unit { int pm, pn, sel; };
struct Gemm { const bf16_t* A; const bf16_t* Bt; int M, N, K; const bf16_t* A2; const bf16_t* Bt2; };

struct StaticOrder {
    int nM, nN, nwg, G, c;
    __host__ __device__ void init(int M, int N, int G_, int c_) { nM = M / BM; nN = N / BM; nwg = nM * nN; G = G_; c = c_; }
    __host__ __device__ bool next(int i, Unit& u) const {
        const long L = (long)i * G + c; if (L >= nwg) return false;
        int wgid = (int)L; { const int q = nwg / NXCD, r = nwg % NXCD, xcd = wgid % NXCD, off = wgid / NXCD; wgid = (xcd < r ? xcd * (q + 1) : r * (q + 1) + (xcd - r) * q) + off; }
        const int nig = WGM * nN, gid = wgid / nig, fm = gid * WGM, gsz = (nM - fm) < WGM ? (nM - fm) : WGM;
        u.pm = fm + ((wgid % nig) % gsz); u.pn = (wgid % nig) / gsz; return true;
    }
    __device__ __forceinline__ void a_ready(const Unit&) const {}
    __device__ __forceinline__ void done(const Unit&) const {}
};

__device__ __forceinline__ unsigned cvt_pk_bf16(float lo, float hi) { unsigned r; asm volatile("v_cvt_pk_bf16_f32 %0, %1, %2" : "=v"(r) : "v"(lo), "v"(hi)); return r; }
template <class Epi, class Sched, bool ALIGN_EPI = false, bool SP2 = false>
__device__ __forceinline__ void gemm_phase(PG8_LAS unsigned char* lds, const Gemm g, const Sched& S, const Epi& E, int wave_s) {
    int tid_ = fresh_tid(wave_s);
    const int tid = tid_, wid = __builtin_amdgcn_readfirstlane(tid >> 6), lane = tid & 63, wr = wid >> 2, wc = wid & 3, fr = lane & 15, fq = lane >> 4;
    const int K = g.K, nt = K / BK;
    unsigned voffA[2], voffB[2];
#pragma unroll
    for (int i = 0; i < 2; ++i) { int R, C; stage_rc(tid * 16 + i * 8192, R, C); const int Rb = Epi::PERM ? ((R & ~31) + perm32(R & 31)) : R;
        voffA[i] = (unsigned)(R * K + C) * 2u; voffB[i] = (unsigned)(Rb * K + C) * 2u; }
    const size_t kstep = (size_t)(BK * 2);
    const size_t hstep = (size_t)HALF * K * 2;
    const size_t tstep = 2 * hstep;
    const unsigned ldsw = (unsigned)wid * 1024u;
    const int aoff = lds_byte(wr * 64 + fr, fq * 8), boff = lds_byte(wc * 32 + fr, fq * 8);
#define PG8_SA(b, h) (((b) * 2 + (h)) * HTB)
#define PG8_SB(b, h) ((4 + (b) * 2 + (h)) * HTB)
#define PG8_STAGE(bufoff, gbase, voff) do { _Pragma("unroll") for (int _i = 0; _i < 2; ++_i) \
        __builtin_amdgcn_global_load_lds((const unsigned*)((const char*)(gbase) + (voff)[_i]), (PG8_LAS unsigned*)(lds + (bufoff) + ldsw + _i * 8192), 16, 0, 0); } while (0)
#define PG8_LDA(dst, b, h) do { _Pragma("unroll") for (int m = 0; m < 4; ++m) _Pragma("unroll") for (int k = 0; k < 2; ++k) dst[m][k] = *(const PG8_LAS bf16x8*)(lds + PG8_SA(b, h) + aoff + m * 2048 + k * 1024); } while (0)
#define PG8_LDB(dst, b, h) do { _Pragma("unroll") for (int n = 0; n < 2; ++n) _Pragma("unroll") for (int k = 0; k < 2; ++k) dst[n][k] = *(const PG8_LAS bf16x8*)(lds + PG8_SB(b, h) + boff + n * 2048 + k * 1024); } while (0)
#define PG8_MMA(ai, bj, At, Bt) do { __builtin_amdgcn_s_setprio(1); _Pragma("unroll") for (int m = 0; m < 4; ++m) _Pragma("unroll") for (int n = 0; n < 2; ++n) _Pragma("unroll") for (int k = 0; k < 2; ++k) \
        acc[ai][bj][m][n] = __builtin_amdgcn_mfma_f32_16x16x32_bf16(Bt[n][k], At[m][k], acc[ai][bj][m][n], 0, 0, 0); __builtin_amdgcn_s_setprio(0); } while (0)
#define PG8_WAIT_V(n) asm volatile("s_waitcnt vmcnt(" #n ")" ::: "memory")
#define PG8_WAIT_L(n) asm volatile("s_waitcnt lgkmcnt(" #n ")" ::: "memory")
#define PG8_BAR __builtin_amdgcn_s_barrier()
#define PG8_SCHED __builtin_amdgcn_sched_barrier(0)
    Unit cur, nxt; int ui = 0;
    if (!S.next(0, cur)) return;
    f32x4 acc[2][2][4][2];
#pragma unroll
    for (int a = 0; a < 2; ++a)
#pragma unroll
        for (int b = 0; b < 2; ++b)
#pragma unroll
            for (int m = 0; m < 4; ++m)
#pragma unroll
                for (int n = 0; n < 2; ++n) acc[a][b][m][n] = (f32x4){0.f, 0.f, 0.f, 0.f};
    bf16x8 At[4][2], B0[2][2], B1[2][2];
    const char* cA; const char* cB;
    if constexpr (Epi::FUSED2) { cA = (const char*)(cur.sel ? g.A2 : g.A) + (size_t)cur.pm * tstep; cB = (const char*)(cur.sel ? g.Bt2 : g.Bt) + (size_t)cur.pn * tstep; }
    else { cA = (const char*)g.A + (size_t)cur.pm * tstep; cB = (const char*)g.Bt + (size_t)cur.pn * tstep; }
    S.a_ready(cur);
    if constexpr (SP2) {
        PG8_STAGE(PG8_SB(0, 0), cB, voffB); PG8_STAGE(PG8_SB(0, 1), cB + hstep, voffB); PG8_STAGE(PG8_SA(0, 0), cA, voffA); PG8_STAGE(PG8_SA(0, 1), cA + hstep, voffA);
        if (wr == 1) PG8_BAR;
        PG8_WAIT_V(2); PG8_BAR;
        PG8_STAGE(PG8_SB(1, 0), cB + kstep, voffB); PG8_STAGE(PG8_SA(1, 0), cA + kstep, voffA); PG8_STAGE(PG8_SB(1, 1), cB + hstep + kstep, voffB);
        PG8_WAIT_V(6); PG8_BAR;
    } else {
        PG8_STAGE(PG8_SB(0, 0), cB, voffB); PG8_STAGE(PG8_SA(0, 0), cA, voffA); PG8_STAGE(PG8_SB(0, 1), cB + hstep, voffB); PG8_STAGE(PG8_SA(0, 1), cA + hstep, voffA);
        if (wr == 1) PG8_BAR;
        PG8_WAIT_V(4); PG8_BAR;
        PG8_STAGE(PG8_SB(1, 0), cB + kstep, voffB); PG8_STAGE(PG8_SA(1, 0), cA + kstep, voffA); PG8_STAGE(PG8_SB(1, 1), cB + hstep + kstep, voffB);
        PG8_WAIT_V(6); PG8_BAR;
    }
    for (;;) {
        const bool has_next = S.next(ui + 1, nxt);
        const char* nA; const char* nB;
        if constexpr (Epi::FUSED2) { nA = has_next ? (const char*)(nxt.sel ? g.A2 : g.A) + (size_t)nxt.pm * tstep : cA; nB = has_next ? (const char*)(nxt.sel ? g.Bt2 : g.Bt) + (size_t)nxt.pn * tstep : cB; }
        else { nA = has_next ? (const char*)g.A + (size_t)nxt.pm * tstep : cA; nB = has_next ? (const char*)g.Bt + (size_t)nxt.pn * tstep : cB; }
#pragma unroll 1
        for (int t = 0; t < nt; t += 2) {
            const bool last = (t == nt - 2);
            const char* a1 = cA + (size_t)(t + 1) * kstep;
            const char* a2 = last ? nA : cA + (size_t)(t + 2) * kstep; const char* b2 = last ? nB : cB + (size_t)(t + 2) * kstep;
            const char* a3 = a2 + kstep; const char* b3 = b2 + kstep;
            if (last && has_next) S.a_ready(nxt);
            if constexpr (SP2) {
            PG8_LDB(B0, 0, 0); PG8_LDB(B1, 0, 1); PG8_SCHED; PG8_LDA(At, 0, 0); PG8_STAGE(PG8_SA(1, 1), a1 + hstep, voffA);
            PG8_WAIT_V(8); PG8_WAIT_L(0); PG8_BAR; PG8_MMA(0, 0, At, B0); PG8_MMA(0, 1, At, B1); PG8_BAR; PG8_SCHED;
            PG8_LDA(At, 0, 1); PG8_STAGE(PG8_SB(0, 0), b2, voffB); PG8_STAGE(PG8_SB(0, 1), b2 + hstep, voffB); PG8_STAGE(PG8_SA(0, 0), a2, voffA);
            PG8_WAIT_V(8); PG8_WAIT_L(0); PG8_BAR; PG8_MMA(1, 0, At, B0); PG8_MMA(1, 1, At, B1); PG8_BAR; PG8_SCHED;
            PG8_LDB(B0, 1, 0); PG8_LDB(B1, 1, 1); PG8_SCHED; PG8_LDA(At, 1, 0); PG8_STAGE(PG8_SA(0, 1), a2 + hstep, voffA);
            PG8_WAIT_V(8); PG8_WAIT_L(0); PG8_BAR; PG8_MMA(0, 0, At, B0); PG8_MMA(0, 1, At, B1); PG8_BAR; PG8_SCHED;
            PG8_LDA(At, 1, 1); PG8_STAGE(PG8_SB(1, 0), b3, voffB); PG8_STAGE(PG8_SB(1, 1), b3 + hstep, voffB); PG8_STAGE(PG8_SA(1, 0), a3, voffA);
            PG8_WAIT_V(8); PG8_WAIT_L(0); PG8_BAR; PG8_MMA(1, 0, At, B0); PG8_MMA(1, 1, At, B1); PG8_BAR; PG8_SCHED;
            } else {
            PG8_LDB(B0, 0, 0); PG8_SCHED; PG8_LDA(At, 0, 0); PG8_STAGE(PG8_SA(1, 1), a1 + hstep, voffA);
            PG8_WAIT_L(8); PG8_BAR; PG8_WAIT_L(0); PG8_MMA(0, 0, At, B0); PG8_BAR; PG8_SCHED;
            PG8_LDB(B1, 0, 1); PG8_STAGE(PG8_SB(0, 0), b2, voffB);
            PG8_BAR; PG8_WAIT_L(0); PG8_MMA(0, 1, At, B1); PG8_BAR;
            PG8_LDA(At, 0, 1); PG8_STAGE(PG8_SA(0, 0), a2, voffA);
            PG8_BAR; PG8_WAIT_L(0); PG8_MMA(1, 0, At, B0); PG8_BAR; PG8_SCHED;
            PG8_STAGE(PG8_SB(0, 1), b2 + hstep, voffB);
            PG8_WAIT_V(6); PG8_BAR; PG8_MMA(1, 1, At, B1); PG8_BAR;
            PG8_LDB(B0, 1, 0); PG8_SCHED; PG8_LDA(At, 1, 0); PG8_STAGE(PG8_SA(0, 1), a2 + hstep, voffA);
            PG8_WAIT_L(8); PG8_BAR; PG8_WAIT_L(0); PG8_MMA(0, 0, At, B0); PG8_BAR; PG8_SCHED;
            PG8_LDB(B1, 1, 1); PG8_STAGE(PG8_SB(1, 0), b3, voffB);
            PG8_BAR; PG8_WAIT_L(0); PG8_MMA(0, 1, At, B1); PG8_BAR;
            PG8_LDA(At, 1, 1); PG8_STAGE(PG8_SA(1, 0), a3, voffA);
            PG8_BAR; PG8_WAIT_L(0); PG8_MMA(1, 0, At, B0); PG8_BAR; PG8_SCHED;
            PG8_STAGE(PG8_SB(1, 1), b3 + hstep, voffB);
            PG8_WAIT_V(6); PG8_BAR; PG8_MMA(1, 1, At, B1); PG8_BAR;
            }
        }
        if constexpr (ALIGN_EPI) { if (wr == 0) PG8_BAR; }
        if constexpr (!Epi::AFTER_DRAIN) { E(acc, cur, wr, wc, fr, fq); S.done(cur); }
        if (!has_next) break;
        bool keep_acc = false; if constexpr (Epi::FUSED2) keep_acc = (nxt.sel != 0);
        if (!keep_acc) {
#pragma unroll
        for (int a = 0; a < 2; ++a)
#pragma unroll
            for (int b = 0; b < 2; ++b)
#pragma unroll
                for (int m = 0; m < 4; ++m)
#pragma unroll
                    for (int n = 0; n < 2; ++n) acc[a][b][m][n] = (f32x4){0.f, 0.f, 0.f, 0.f};
        }
        cur = nxt; cA = nA; cB = nB; ++ui;
        if constexpr (ALIGN_EPI) { if (wr == 1) PG8_BAR; }
    }
    PG8_WAIT_V(0);
    if constexpr (!ALIGN_EPI) { if (wr == 0) PG8_BAR; }
    PG8_BAR;
    if constexpr (Epi::AFTER_DRAIN) { E.fused(acc, cur, wr, wc, fr, fq, lds, wid, lane); S.done(cur); }
#undef PG8_SA
#undef PG8_SB
#undef PG8_STAGE
#undef PG8_LDA
#undef PG8_LDB
#undef PG8_MMA
#undef PG8_WAIT_V
#undef PG8_WAIT_L
#undef PG8_BAR
#undef PG8_SCHED
}
}

#include <hip/hip_cooperative_groups.h>
namespace cg = cooperative_groups;
using namespace pg8;
#define LAS __attribute__((address_space(3)))
typedef float f32x16 __attribute__((ext_vector_type(16)));
typedef unsigned u32x2 __attribute__((ext_vector_type(2)));

constexpr int TOK = 65536, DM = 1024, SEQ = 2048, NB = 32, NH = 8, PLE = 256;
constexpr int NMAIN = 9216;
constexpr float LOG2E = 1.4426950408889634f;
constexpr float QSCALE = 0.125f * LOG2E;
constexpr float ALPHA = 1.189207115002721f;
constexpr float LAMBDA_INIT = 0.2f;
constexpr float LN_EPS = 1e-5f, RMS_EPS = 1e-5f;

constexpr size_t MiB = 1u << 20, SLOT = 128 * MiB;
constexpr size_t WS_WIN = 0, WS_WA = 20 * MiB, WS_WB = 22 * MiB, WS_WOUT = 24 * MiB, WS_WG = 26 * MiB, WS_WPLE = 28 * MiB, WS_PB = 32 * MiB;
constexpr size_t WS_XB = 1 * SLOT;
constexpr size_t WS_HCU = 2 * SLOT;
constexpr size_t WS_GAP = 3 * SLOT;
constexpr size_t WS_Q = 4 * SLOT;
constexpr size_t WS_K = 5 * SLOT;
constexpr size_t WS_VT = 6 * SLOT;
constexpr size_t WS_SZB = 7 * SLOT;
constexpr size_t WS_END = 8 * SLOT;

constexpr int LDS_BYTES = 147456;

struct Args {
    const float* x; const float* p; const float* w_in; const float* conv_w; const float* conv_b; const float* w_proj_a;
    const float* lq1; const float* lk1; const float* lq2; const float* lk2; const float* subln_g; const float* w_proj_b;
    const float* w_out; const float* w_ple; const float* w_ple_gate; const float* ln_g; const float* ln_b;
    float* out; unsigned char* ws;
};

__device__ __forceinline__ unsigned f2bf(float f) { unsigned u = __builtin_bit_cast(unsigned, f); return (u + 0x7fffu + ((u >> 16) & 1u)) >> 16; }
__device__ __forceinline__ unsigned pk2(float lo, float hi) { return cvt_pk_bf16(lo, hi); }
__device__ __forceinline__ float bf_lo(unsigned u) { return __builtin_bit_cast(float, u << 16); }
__device__ __forceinline__ float bf_hi(unsigned u) { return __builtin_bit_cast(float, u & 0xffff0000u); }
__device__ __forceinline__ float sigmoidf_(float v) { return __builtin_amdgcn_rcpf(1.0f + __builtin_amdgcn_exp2f(-v * LOG2E)); }
__device__ __forceinline__ f32x4 sig4(f32x4 v) { return (f32x4){sigmoidf_(v[0]), sigmoidf_(v[1]), sigmoidf_(v[2]), sigmoidf_(v[3])}; }
__device__ __forceinline__ u32x4 pack8(f32x4 a, f32x4 b) { u32x4 w; w.x = pk2(a[0], a[1]); w.y = pk2(a[2], a[3]); w.z = pk2(b[0], b[1]); w.w = pk2(b[2], b[3]); return w; }
__device__ __forceinline__ void unpack8(u32x4 w, f32x4& a, f32x4& b) { a = (f32x4){bf_lo(w.x), bf_hi(w.x), bf_lo(w.y), bf_hi(w.y)}; b = (f32x4){bf_lo(w.z), bf_hi(w.z), bf_lo(w.w), bf_hi(w.w)}; }

struct PanelOrder {
    int panel, nN;
    __host__ __device__ bool next(int i, Unit& u) const { if (i >= nN) return false; u.pm = panel; u.pn = i; u.sel = 0; return true; }
    __device__ __forceinline__ void a_ready(const Unit&) const {}
    __device__ __forceinline__ void done(const Unit&) const {}
};
struct EpiProj {
    static constexpr bool PERM = true, AFTER_DRAIN = false, FUSED2 = false;
    bf16_t *hcu, *gap, *q, *k, *szb, *sga, *sgb;
    __device__ __forceinline__ void operator()(const f32x4 (&acc)[2][2][4][2], const Unit& u, int wr, int wc, int fr, int fq) const {
        const int row0 = u.pm * BM + wr * 64 + fr;
        if (u.pn < 16) {
            bf16_t* base = (wc < 2) ? hcu : gap;
            const int col = u.pn * 64 + (wc & 1) * 32 + 8 * fq;
#pragma unroll
            for (int ai = 0; ai < 2; ++ai)
#pragma unroll
                for (int m = 0; m < 4; ++m) {
                    f32x4 a0 = acc[ai][0][m][0], a1 = acc[ai][0][m][1], b0 = acc[ai][1][m][0], b1 = acc[ai][1][m][1];
                    if (wc >= 2) { b0 = b0 * sig4(b0); b1 = b1 * sig4(b1); }
                    *(u32x4*)(base + (size_t)(row0 + ai * HALF + m * 16) * DM + col) = pack8(a0 * b0, a1 * b1);
                }
        } else {
            const int t = (u.pn - 16) >> 2;
            bf16_t* base = sga;
            if (t < 3) base = q + (size_t)(t == 2 ? 3 : t) * (SLOT / 2);
            const int col = ((u.pn - 16) & 3) * 256 + wc * 32 + 8 * fq;
#pragma unroll
            for (int ai = 0; ai < 2; ++ai)
#pragma unroll
                for (int m = 0; m < 4; ++m)
#pragma unroll
                    for (int bj = 0; bj < 2; ++bj) {
                        f32x4 v0 = acc[ai][bj][m][0], v1 = acc[ai][bj][m][1];
                        if (t == 0) { v0 = v0 * QSCALE; v1 = v1 * QSCALE; }
                        else if (t == 2) { v0 = v0 * sig4(v0); v1 = v1 * sig4(v1); }
                        else if (t >= 3) { v0 = sig4(v0); v1 = sig4(v1); }
                        const unsigned row = (unsigned)(row0 + ai * HALF + m * 16), cc = (unsigned)(col + bj * HALF);
                        unsigned off = row * DM + cc;
                        if (t >= 3) off = (row >> 8) * 524288u + (unsigned)(t - 3) * 262144u + (row & 255u) * DM + cc;
                        if (t == 1) off = (((((row >> 11) * 8u + (cc >> 7)) * 2u + ((cc >> 6) & 1u)) * 32u + ((row & 2047u) >> 6)) * 64u + (row & 63u)) * 64u + (cc & 63u);
                        *(u32x4*)(base + off) = pack8(v0, v1);
                    }
        }
    }
};
struct EpiVT {
    static constexpr bool PERM = true, AFTER_DRAIN = false, FUSED2 = false;
    bf16_t* vT;
    __device__ __forceinline__ void operator()(const f32x4 (&acc)[2][2][4][2], const Unit& u, int wr, int wc, int fr, int fq) const {
        const int row0 = u.pm * BM + wr * 64 + fr;
        const int col0 = u.pn * BM + wc * 32 + 8 * fq;
        const int b = col0 >> 11;
#pragma unroll
        for (int ai = 0; ai < 2; ++ai)
#pragma unroll
            for (int m = 0; m < 4; ++m)
#pragma unroll
                for (int bj = 0; bj < 2; ++bj) {
                    const int row = row0 + ai * HALF + m * 16, s = (col0 & 2047) + bj * HALF;
                    *(u32x4*)(vT + ((size_t)(((b * 8 + (row >> 7)) * 32 + (s >> 6)) * 128 + (row & 127))) * 64 + (s & 63)) = pack8(acc[ai][bj][m][0], acc[ai][bj][m][1]);
                }
    }
};
struct EpiStore {
    static constexpr bool PERM = true, AFTER_DRAIN = false, FUSED2 = false;
    bf16_t* O; static constexpr int ldc = DM;
    __device__ __forceinline__ void operator()(const f32x4 (&acc)[2][2][4][2], const Unit& u, int wr, int wc, int fr, int fq) const {
        const int row0 = u.pm * BM + wr * 64 + fr, col0 = u.pn * BM + wc * 32 + 8 * fq;
#pragma unroll
        for (int ai = 0; ai < 2; ++ai)
#pragma unroll
            for (int m = 0; m < 4; ++m)
#pragma unroll
                for (int bj = 0; bj < 2; ++bj)
                    *(u32x4*)(O + (size_t)(row0 + ai * HALF + m * 16) * ldc + col0 + bj * HALF) = pack8(acc[ai][bj][m][0], acc[ai][bj][m][1]);
    }
};
template <int MODE> struct EpiGate {
    static constexpr bool PERM = true, AFTER_DRAIN = false, FUSED2 = false;
    const bf16_t* gate; bf16_t* O;
    __device__ __forceinline__ void operator()(const f32x4 (&acc)[2][2][4][2], const Unit& u, int wr, int wc, int fr, int fq) const {
        const int row0 = u.pm * BM + wr * 64 + fr, col0 = u.pn * BM + wc * 32 + 8 * fq;
        const unsigned gbase = (unsigned)u.pm * 524288u + (unsigned)MODE * 262144u + (unsigned)(wr * 64 + fr) * DM + (unsigned)col0;
        const unsigned obase = (unsigned)row0 * DM + (unsigned)col0;
        u32x4 gv[2][2][2], tv[2][2][2];
#define EG_LOAD(q) do { _Pragma("unroll") for (int ml = 0; ml < 2; ++ml) _Pragma("unroll") for (int bj = 0; bj < 2; ++bj) { const int ai = (q) >> 1, m = 2 * ((q) & 1) + ml; \
            gv[(q) & 1][ml][bj] = *(const u32x4*)(gate + gbase + (unsigned)(ai * HALF + m * 16) * DM + bj * HALF); \
            if (MODE == 1) tv[(q) & 1][ml][bj] = *(const u32x4*)(O + (obase + (unsigned)((ai * HALF + m * 16) * DM + bj * HALF))); } } while (0)
#define EG_PROC(q) do { _Pragma("unroll") for (int ml = 0; ml < 2; ++ml) _Pragma("unroll") for (int bj = 0; bj < 2; ++bj) { const int ai = (q) >> 1, m = 2 * ((q) & 1) + ml; \
            f32x4 g0, g1; unpack8(gv[(q) & 1][ml][bj], g0, g1); \
            f32x4 v0 = g0 * acc[ai][bj][m][0], v1 = g1 * acc[ai][bj][m][1]; \
            if (MODE == 1) { f32x4 t0, t1; unpack8(tv[(q) & 1][ml][bj], t0, t1); v0 = v0 + t0; v1 = v1 + t1; } \
            *(u32x4*)(O + (obase + (unsigned)((ai * HALF + m * 16) * DM + bj * HALF))) = pack8(v0, v1); } } while (0)
        EG_LOAD(0); EG_LOAD(1); EG_PROC(0); EG_LOAD(2); EG_PROC(1); EG_LOAD(3); EG_PROC(2); EG_PROC(3);
#undef EG_LOAD
#undef EG_PROC
    }
};
struct EpiMerge {
    static constexpr bool PERM = true, AFTER_DRAIN = false, FUSED2 = true;
    const bf16_t* gate; bf16_t* O;
    __device__ __forceinline__ void operator()(f32x4 (&acc)[2][2][4][2], const Unit& u, int wr, int wc, int fr, int fq) const {
        const int row0 = u.pm * BM + wr * 64 + fr, col0 = u.pn * BM + wc * 32 + 8 * fq;
        const unsigned gbase = (unsigned)u.pm * 524288u + (unsigned)(wr * 64 + fr) * DM + (unsigned)col0;
        const unsigned obase = (unsigned)row0 * DM + (unsigned)col0;
        u32x4 ga_[2][2][2], gb_[2][2][2];
#define EM_LOAD(q) do { _Pragma("unroll") for (int ml = 0; ml < 2; ++ml) _Pragma("unroll") for (int bj = 0; bj < 2; ++bj) { const int ai = (q) >> 1, m = 2 * ((q) & 1) + ml; \
            const unsigned go_ = gbase + (unsigned)((ai * HALF + m * 16) * DM + bj * HALF); \
            gb_[(q) & 1][ml][bj] = *(const u32x4*)(gate + go_ + 262144u); if (!u.sel) ga_[(q) & 1][ml][bj] = *(const u32x4*)(gate + go_); } } while (0)
#define EM_PROC(q) do { _Pragma("unroll") for (int ml = 0; ml < 2; ++ml) _Pragma("unroll") for (int bj = 0; bj < 2; ++bj) { const int ai = (q) >> 1, m = 2 * ((q) & 1) + ml; \
            f32x4 b0, b1; unpack8(gb_[(q) & 1][ml][bj], b0, b1); \
            if (!u.sel) { f32x4 a0, a1; unpack8(ga_[(q) & 1][ml][bj], a0, a1); \
                _Pragma("unroll") for (int i = 0; i < 4; ++i) { acc[ai][bj][m][0][i] *= a0[i] * __builtin_amdgcn_rcpf(__builtin_fmaxf(b0[i], 1e-30f)); acc[ai][bj][m][1][i] *= a1[i] * __builtin_amdgcn_rcpf(__builtin_fmaxf(b1[i], 1e-30f)); } } \
            else { *(u32x4*)(O + (obase + (unsigned)((ai * HALF + m * 16) * DM + bj * HALF))) = pack8(acc[ai][bj][m][0] * b0, acc[ai][bj][m][1] * b1); } } } while (0)
        EM_LOAD(0); EM_LOAD(1); EM_PROC(0); EM_LOAD(2); EM_PROC(1); EM_LOAD(3); EM_PROC(2); EM_PROC(3);
#undef EM_LOAD
#undef EM_PROC
    }
};
struct PanelOrder2 {
    int panel, nN;
    __host__ __device__ bool next(int i, Unit& u) const { if (i >= 2 * nN) return false; u.pm = panel; u.pn = i >> 1; u.sel = i & 1; return true; }
    __device__ __forceinline__ void a_ready(const Unit&) const {}
    __device__ __forceinline__ void done(const Unit&) const {}
};
struct EpiRes {
    static constexpr bool PERM = true, AFTER_DRAIN = false, FUSED2 = false;
    const float* x; float* r; bf16_t* rb;
    __device__ __forceinline__ void operator()(const f32x4 (&acc)[2][2][4][2], const Unit& u, int wr, int wc, int fr, int fq) const {
        const int row0 = u.pm * BM + wr * 64 + fr, col0 = u.pn * BM + wc * 32 + 8 * fq;
        const unsigned obase = (unsigned)row0 * DM + (unsigned)col0;
        f32x4 xs[2][2][2][2];
#define ER_LOAD(q) do { _Pragma("unroll") for (int ml = 0; ml < 2; ++ml) _Pragma("unroll") for (int bj = 0; bj < 2; ++bj) { const int ai = (q) >> 1, m = 2 * ((q) & 1) + ml; \
            const unsigned off = obase + (unsigned)((ai * HALF + m * 16) * DM + bj * HALF); \
            xs[(q) & 1][ml][bj][0] = *(const f32x4*)(x + off); xs[(q) & 1][ml][bj][1] = *(const f32x4*)(x + off + 4); } } while (0)
#define ER_PROC(q) do { _Pragma("unroll") for (int ml = 0; ml < 2; ++ml) _Pragma("unroll") for (int bj = 0; bj < 2; ++bj) { const int ai = (q) >> 1, m = 2 * ((q) & 1) + ml; \
            const unsigned off = obase + (unsigned)((ai * HALF + m * 16) * DM + bj * HALF); \
            const f32x4 v0 = xs[(q) & 1][ml][bj][0] * ALPHA + acc[ai][bj][m][0], v1 = xs[(q) & 1][ml][bj][1] * ALPHA + acc[ai][bj][m][1]; \
            *(u32x4*)(rb + off) = pack8(v0, v1); } } while (0)
        ER_LOAD(0); ER_LOAD(1); ER_PROC(0); ER_LOAD(2); ER_PROC(1); ER_LOAD(3); ER_PROC(2); ER_PROC(3);
#undef ER_LOAD
#undef ER_PROC
    }
};
struct EpiPle {
    static constexpr bool PERM = true, AFTER_DRAIN = false, FUSED2 = false;
    bf16_t* ple;
    __device__ __forceinline__ void operator()(const f32x4 (&acc)[2][2][4][2], const Unit& u, int wr, int wc, int fr, int fq) const {
        const int row0 = u.pm * BM + wr * 64 + fr, col0 = u.pn * BM + wc * 32 + 8 * fq;
        const unsigned obase = (unsigned)row0 * DM + (unsigned)col0;
        u32x4 ev[2][2][2];
#define EP_LOAD(q) do { _Pragma("unroll") for (int ml = 0; ml < 2; ++ml) _Pragma("unroll") for (int bj = 0; bj < 2; ++bj) { const int ai = (q) >> 1, m = 2 * ((q) & 1) + ml; \
            ev[(q) & 1][ml][bj] = *(const u32x4*)(ple + (obase + (unsigned)((ai * HALF + m * 16) * DM + bj * HALF))); } } while (0)
#define EP_PROC(q) do { _Pragma("unroll") for (int ml = 0; ml < 2; ++ml) _Pragma("unroll") for (int bj = 0; bj < 2; ++bj) { const int ai = (q) >> 1, m = 2 * ((q) & 1) + ml; \
            f32x4 e0, e1; unpack8(ev[(q) & 1][ml][bj], e0, e1); \
            *(u32x4*)(ple + (obase + (unsigned)((ai * HALF + m * 16) * DM + bj * HALF))) = pack8(sig4(acc[ai][bj][m][0]) * e0, sig4(acc[ai][bj][m][1]) * e1); } } while (0)
        EP_LOAD(0); EP_LOAD(1); EP_PROC(0); EP_LOAD(2); EP_PROC(1); EP_LOAD(3); EP_PROC(2); EP_PROC(3);
#undef EP_LOAD
#undef EP_PROC
    }
};

template <int CTRL> __device__ __forceinline__ float dppf(float v) { return __builtin_bit_cast(float, __builtin_amdgcn_update_dpp(0, __builtin_bit_cast(int, v), CTRL, 0xf, 0xf, true)); }
__device__ __forceinline__ float row16_sum(float v) { v += dppf<0xB1>(v); v += dppf<0x4E>(v); v += dppf<0x141>(v); v += dppf<0x140>(v); return v; }
__device__ __forceinline__ void swap16(float v, float& a, float& b) { a = v; b = v; asm volatile("s_nop 1\n\tv_permlane16_swap_b32 %0, %1\n\ts_nop 1" : "+v"(a), "+v"(b)); }
__device__ __forceinline__ void swap32(float v, float& a, float& b) { a = v; b = v; asm volatile("s_nop 1\n\tv_permlane32_swap_b32 %0, %1\n\ts_nop 1" : "+v"(a), "+v"(b)); }
__device__ __forceinline__ float xor16_sum(float v) { float a, b; swap16(v, a, b); return a + b; }
__device__ __forceinline__ float xor32_sum(float v) { float a, b; swap32(v, a, b); return a + b; }
__device__ __forceinline__ float xor32_max(float v) { float a, b; swap32(v, a, b); return __builtin_fmaxf(a, b); }
__device__ __forceinline__ float wave_sum(float v) { return xor32_sum(xor16_sum(row16_sum(v))); }
__device__ __forceinline__ void transpose_item(const float* W, int K, int N, bf16_t* WT, int k0, int n_src, int n_dst, LAS float* scr, int lane) {
#pragma unroll 8
    for (int i = 0; i < 32; ++i) { const int kk = 2 * i + (lane >> 5); scr[kk * 33 + (lane & 31)] = W[(size_t)(k0 + kk) * N + n_src + (lane & 31)]; }
    asm volatile("s_waitcnt lgkmcnt(0)" ::: "memory");
    const int c = lane & 7;
#pragma unroll
    for (int j = 0; j < 4; ++j) { const int n = (lane >> 3) + 8 * j; const LAS float* s = scr + (8 * c) * 33 + n;
        u32x4 o; o.x = pk2(s[0 * 33], s[1 * 33]); o.y = pk2(s[2 * 33], s[3 * 33]); o.z = pk2(s[4 * 33], s[5 * 33]); o.w = pk2(s[6 * 33], s[7 * 33]);
        *(u32x4*)(WT + (size_t)(n_dst + n) * K + k0 + 8 * c) = o; }
    asm volatile("s_waitcnt lgkmcnt(0)" ::: "memory");
}
__device__ __forceinline__ int win_colmap(int np) {
    if (np < 4096) { const int tile = np >> 8, half = (np >> 7) & 1, c = np & 127, which = c >> 6, ch = 64 * tile + (c & 63);
        const int base = half == 0 ? (which == 0 ? 0 : 2048) : (which == 0 ? 1024 : 3072); return base + ch; }
    if (np < 6144) return np;
    if (np < NMAIN) return np + 1024;
    return 6144 + (np - NMAIN);
}
__device__ __forceinline__ void cvt_rows(const float* src, bf16_t* dst, size_t n8, int gtid, int gthreads) {
    for (size_t i = gtid; i < n8; i += gthreads) {
        const f32x4 a = *(const f32x4*)(src + i * 8), b = *(const f32x4*)(src + i * 8 + 4);
        *(u32x4*)(dst + i * 8) = pack8(a, b);
    }
}

__device__ __forceinline__ int crow(int r, int hi) { return (r & 3) + 8 * (r >> 2) + 4 * hi; }
__device__ __forceinline__ float max3f(float a, float b, float c) { float r; asm("v_max3_f32 %0, %1, %2, %3" : "=v"(r) : "v"(a), "v"(b), "v"(c)); return r; }
constexpr int KSLOT = 16384, VSLOT = 16384, ATT_K = 0, ATT_V = 3 * KSLOT, ATT_X = 0, ATT_WS = 131072;
__device__ __forceinline__ void glds16(const void* g, LAS unsigned char* l) { __builtin_amdgcn_global_load_lds((const unsigned*)g, (LAS unsigned*)l, 16, 0, 0); }

__device__ __forceinline__ void attn_unit(LAS unsigned char* lds, const bf16_t* __restrict__ q, const bf16_t* __restrict__ k, const bf16_t* __restrict__ vT,
                                          const bf16_t* __restrict__ szb, bf16_t* __restrict__ o_out, const float* __restrict__ subln_g, float lam, int b, int h, int qb, int wave_s) {
    int tid_ = fresh_tid(wave_s);
    const int tid = tid_, lane = tid & 63, r32 = lane & 31, hi = lane >> 5; const int wid = __builtin_amdgcn_readfirstlane(tid >> 6);
    const int mp = wid >> 2, wq = wid & 3;
    const float m2 = __builtin_amdgcn_exp2f(-(float)(h + 1)) * LOG2E;
    LAS float* wsf = (LAS float*)(lds + ATT_WS) + wid * 64;
    const int T0 = qb * 128 + wq * 32, tpos = T0 + r32;
    const int krow = (r32 & 0x13) | ((r32 & 4) << 1) | ((r32 & 8) >> 1);
    const int kr = 8 * wid + (lane >> 3);
    const unsigned kgo = (unsigned)((b * 8 + h) * 2 * 32 * 4096 + kr * 64 + (((lane & 7) ^ ((kr >> 1) & 7)) * 8));
    const unsigned vgo = (unsigned)((b * 8 + h) * 32 * 8192 + kr * 64 + (((lane & 7) ^ ((kr >> 1) & 7)) * 8));
    LAS unsigned char* kdst = lds + ATT_K + wid * 1024;
    LAS unsigned char* vdst = lds + ATT_V + wid * 1024;
#define DMA_K(tile, slot) do { const unsigned o_ = kgo + (unsigned)(tile) * 4096; glds16(k + o_, kdst + (slot) * KSLOT); glds16(k + o_ + 32 * 4096, kdst + (slot) * KSLOT + 8192); } while (0)
#define DMA_V(tile, slot) do { const unsigned o_ = vgo + (unsigned)(tile) * 8192; glds16(vT + o_, vdst + (slot) * VSLOT); glds16(vT + o_ + 4096, vdst + (slot) * VSLOT + 8192); } while (0)
#define TILE(j) ((2 * qb + (j)) & 31)
    int koffs[4], voffs[4];
    { const int fk = (krow >> 1) & 7, fv = (r32 >> 1) & 7;
#pragma unroll
      for (int i = 0; i < 4; ++i) { koffs[i] = mp * 8192 + krow * 128 + (((2 * i + hi) ^ fk) << 4); voffs[i] = r32 * 128 + (((2 * i + hi) ^ fv) << 4); } }
    const unsigned m2hi = f2bf(m2), m2lo = f2bf(m2 - __builtin_bit_cast(float, m2hi << 16));
    u32x4 kx0w = {0u, 0u, 0u, 0u}, kx1w = {0u, 0u, 0u, 0u}, qxw = {0u, 0u, 0u, 0u};
    if (hi == 0) {
        const unsigned s0 = f2bf((float)krow), s1 = f2bf((float)(krow + 32)), tr = f2bf((float)r32);
        kx0w.x = (m2hi | (m2lo << 16)) ^ 0x80008000u; kx0w.y = s0 | (s0 << 16);
        kx1w.x = kx0w.x; kx1w.y = s1 | (s1 << 16);
        qxw.x = tr | (tr << 16); qxw.y = m2hi | (m2lo << 16);
    }
    const bf16x8 kx0 = __builtin_bit_cast(bf16x8, kx0w), kx1 = __builtin_bit_cast(bf16x8, kx1w);

    asm volatile("s_waitcnt lgkmcnt(0)\n\ts_barrier" ::: "memory");
    bf16x8 qr[4];
    {
        const bf16_t* qp = q + (size_t)(b * SEQ + tpos) * DM + h * 128 + mp * 64 + hi * 8;
#pragma unroll
        for (int d0 = 0; d0 < 4; ++d0) qr[d0] = *(const bf16x8*)(qp + 16 * d0);
    }
    DMA_K(TILE(0), 0); DMA_K(TILE(1), 1); DMA_V(TILE(0), 0); DMA_K(TILE(2), 2); DMA_V(TILE(1), 1);
    f32x16 o[4];
#pragma unroll
    for (int d0 = 0; d0 < 4; ++d0)
#pragma unroll
        for (int r = 0; r < 16; ++r) o[d0][r] = 0.f;
    float mref = -1e30f, l = 0.f;
    float cstA = 0.f, cstB = 0.f; bool diagA = false, diagB = false;
    f32x16 A0, A1, B0, B1;
    const f32x16 zero16 = {0.f, 0.f, 0.f, 0.f, 0.f, 0.f, 0.f, 0.f, 0.f, 0.f, 0.f, 0.f, 0.f, 0.f, 0.f, 0.f};
#define ATT_SIDE(QX, CST, DIAG, jn) do { \
        const int S0_ = 64 * TILE(jn); u32x4 qs_ = qxw; \
        if (S0_ + 63 <= T0) { CST = -m2 * (float)(T0 - S0_); DIAG = false; } \
        else if (S0_ >= T0 + 31) { CST = -m2 * (float)(S0_ - T0); DIAG = false; qs_.x ^= 0x80008000u; qs_.y ^= 0x80008000u; } \
        else { CST = 0.f; DIAG = true; qs_.x = 0u; qs_.y = 0u; } \
        QX = __builtin_bit_cast(bf16x8, qs_); } while (0)
#define ATT_KREAD(KF, jn) do { const LAS unsigned char* kb_ = lds + ATT_K + ((jn) % 3) * KSLOT; \
        _Pragma("unroll") for (int d0 = 0; d0 < 4; ++d0) { KF[2 * d0] = *(const LAS bf16x8*)(kb_ + koffs[d0]); KF[2 * d0 + 1] = *(const LAS bf16x8*)(kb_ + koffs[d0] + 4096); } } while (0)
#define ATT_QKM(N0, N1, KF, QX) do { \
        N0 = __builtin_amdgcn_mfma_f32_32x32x16_bf16(kx0, QX, zero16, 0, 0, 0); N1 = __builtin_amdgcn_mfma_f32_32x32x16_bf16(kx1, QX, zero16, 0, 0, 0); \
        _Pragma("unroll") for (int d0 = 0; d0 < 4; ++d0) { \
            N0 = __builtin_amdgcn_mfma_f32_32x32x16_bf16(KF[2 * d0], qr[d0], N0, 0, 0, 0); N1 = __builtin_amdgcn_mfma_f32_32x32x16_bf16(KF[2 * d0 + 1], qr[d0], N1, 0, 0, 0); } } while (0)
#define ATT_ROWMAX(RM, X0, X1) do { float a_ = max3f(X0[0], X0[1], X1[0]), b_ = max3f(X0[2], X0[3], X1[1]); a_ = max3f(a_, X1[2], X1[3]); \
        _Pragma("unroll") for (int r = 4; r < 16; r += 4) { a_ = max3f(a_, X0[r], X0[r + 1]); b_ = max3f(b_, X0[r + 2], X0[r + 3]); a_ = max3f(a_, X1[r], X1[r + 1]); b_ = max3f(b_, X1[r + 2], X1[r + 3]); } \
        RM = max3f(a_, b_, b_); } while (0)
#define SB_ __builtin_amdgcn_sched_barrier(0)
#define EXPCH(X, base, n) do { _Pragma("unroll") for (int r = (base); r < (base) + (n); ++r) X[r] = __builtin_amdgcn_exp2f(X[r] - sub_); } while (0)
#define VREAD(VF, ks) do { _Pragma("unroll") for (int d0 = 0; d0 < 4; ++d0) VF[d0] = *(const LAS bf16x8*)(vb_ + voffs[ks] + d0 * 4096); } while (0)
#define PVG(ks, VF, d0, SUMST, MAXST) do { o[d0] = __builtin_amdgcn_mfma_f32_32x32x16_bf16(pa_[ks], VF[d0], o[d0], 0, 0, 0); SUMST; MAXST; SB_; } while (0)
#define ATT_STEP(C0, C1, CCST, CDIAG, RMC, N0, N1, NCST, NDIAG, RMN, j, HN) do { \
        if (CDIAG) { const float dts_ = (float)(tpos - 64 * TILE(j) - 8 * hi); \
            _Pragma("unroll") for (int r = 0; r < 16; ++r) { const float c_ = (float)(16 * (r >> 3) + (r & 7)); \
                C0[r] = __builtin_fmaf(-m2, __builtin_fabsf(dts_ - c_), C0[r]); C1[r] = __builtin_fmaf(-m2, __builtin_fabsf(dts_ - (c_ + 32.f)), C1[r]); } \
            float rm2_; ATT_ROWMAX(rm2_, C0, C1); RMC = xor32_max(rm2_); } \
        if (__any(RMC > mref + 8.0f)) { \
            const float mnew_ = __builtin_fmaxf(mref, RMC); const float f_ = __builtin_amdgcn_exp2f(mref - mnew_); \
            l *= f_; mref = mnew_; \
            if (hi == 0) wsf[r32] = f_; \
            asm volatile("s_waitcnt lgkmcnt(0)" ::: "memory"); \
            _Pragma("unroll") for (int r = 0; r < 16; ++r) { const float fr_ = wsf[crow(r, hi)]; \
                _Pragma("unroll") for (int d0 = 0; d0 < 4; ++d0) o[d0][r] *= fr_; } } \
        const float sub_ = mref - CCST; \
        bf16x8 kf_[8]; bf16x8 qx_ = qr[0]; \
        if (HN) { ATT_SIDE(qx_, NCST, NDIAG, (j) + 1); ATT_KREAD(kf_, (j) + 1); asm volatile("" ::: "memory"); } \
        bf16x8 pa_[4]; u32x4 w_; \
        SB_; \
        if (HN) N0 = __builtin_amdgcn_mfma_f32_32x32x16_bf16(kx0, qx_, zero16, 0, 0, 0); EXPCH(C0, 0, 3); SB_; \
        if (HN) N1 = __builtin_amdgcn_mfma_f32_32x32x16_bf16(kx1, qx_, zero16, 0, 0, 0); EXPCH(C0, 3, 3); SB_; \
        if (HN) N0 = __builtin_amdgcn_mfma_f32_32x32x16_bf16(kf_[0], qr[0], N0, 0, 0, 0); EXPCH(C0, 6, 3); SB_; \
        if (HN) N1 = __builtin_amdgcn_mfma_f32_32x32x16_bf16(kf_[1], qr[0], N1, 0, 0, 0); EXPCH(C0, 9, 3); SB_; \
        if (HN) N0 = __builtin_amdgcn_mfma_f32_32x32x16_bf16(kf_[2], qr[1], N0, 0, 0, 0); EXPCH(C0, 12, 4); SB_; \
        if ((j) + 3 < 32) { DMA_K(TILE((j) + 3), (j) % 3); } SB_; \
        if (HN) N1 = __builtin_amdgcn_mfma_f32_32x32x16_bf16(kf_[3], qr[1], N1, 0, 0, 0); EXPCH(C1, 0, 3); \
          w_.x = pk2(C0[0], C0[1]); w_.y = pk2(C0[2], C0[3]); w_.z = pk2(C0[4], C0[5]); w_.w = pk2(C0[6], C0[7]); pa_[0] = __builtin_bit_cast(bf16x8, w_); SB_; \
        if (HN) N0 = __builtin_amdgcn_mfma_f32_32x32x16_bf16(kf_[4], qr[2], N0, 0, 0, 0); EXPCH(C1, 3, 3); \
          w_.x = pk2(C0[8], C0[9]); w_.y = pk2(C0[10], C0[11]); w_.z = pk2(C0[12], C0[13]); w_.w = pk2(C0[14], C0[15]); pa_[1] = __builtin_bit_cast(bf16x8, w_); SB_; \
        if (HN) N1 = __builtin_amdgcn_mfma_f32_32x32x16_bf16(kf_[5], qr[2], N1, 0, 0, 0); EXPCH(C1, 6, 3); SB_; \
        if (HN) N0 = __builtin_amdgcn_mfma_f32_32x32x16_bf16(kf_[6], qr[3], N0, 0, 0, 0); EXPCH(C1, 9, 3); \
          w_.x = pk2(C1[0], C1[1]); w_.y = pk2(C1[2], C1[3]); w_.z = pk2(C1[4], C1[5]); w_.w = pk2(C1[6], C1[7]); pa_[2] = __builtin_bit_cast(bf16x8, w_); SB_; \
        if (HN) N1 = __builtin_amdgcn_mfma_f32_32x32x16_bf16(kf_[7], qr[3], N1, 0, 0, 0); EXPCH(C1, 12, 4); \
          w_.x = pk2(C1[8], C1[9]); w_.y = pk2(C1[10], C1[11]); w_.z = pk2(C1[12], C1[13]); w_.w = pk2(C1[14], C1[15]); pa_[3] = __builtin_bit_cast(bf16x8, w_); SB_; \
        if ((j) < 29) asm volatile("s_waitcnt vmcnt(4) lgkmcnt(0)\n\ts_barrier" ::: "memory"); \
        else asm volatile("s_waitcnt vmcnt(0) lgkmcnt(0)\n\ts_barrier" ::: "memory"); \
        __builtin_amdgcn_s_setprio(1); \
        { const LAS unsigned char* vb_ = lds + ATT_V + ((j) % 3) * VSLOT; \
          bf16x8 vfa_[4], vfb_[4]; float ls_ = 0.f, ma_ = -3.0e38f; \
          VREAD(vfa_, 0); VREAD(vfb_, 1); asm volatile("" ::: "memory"); SB_; \
          PVG(0, vfa_, 0, ls_ += C0[0] + C0[1], if (HN) ma_ = max3f(ma_, N0[0], N0[1])); \
          PVG(0, vfa_, 1, ls_ += C0[2] + C0[3], if (HN) ma_ = max3f(ma_, N0[2], N0[3])); \
          PVG(0, vfa_, 2, ls_ += C0[4] + C0[5], if (HN) ma_ = max3f(ma_, N0[4], N0[5])); \
          PVG(0, vfa_, 3, ls_ += C0[6] + C0[7], if (HN) ma_ = max3f(ma_, N0[6], N0[7])); \
          VREAD(vfa_, 2); asm volatile("" ::: "memory"); SB_; \
          PVG(1, vfb_, 0, ls_ += C0[8] + C0[9], if (HN) ma_ = max3f(ma_, N0[8], N0[9])); \
          PVG(1, vfb_, 1, ls_ += C0[10] + C0[11], if (HN) ma_ = max3f(ma_, N0[10], N0[11])); \
          PVG(1, vfb_, 2, ls_ += C0[12] + C0[13], if (HN) ma_ = max3f(ma_, N0[12], N0[13])); \
          PVG(1, vfb_, 3, ls_ += C0[14] + C0[15], if (HN) ma_ = max3f(ma_, N0[14], N0[15])); \
          VREAD(vfb_, 3); asm volatile("" ::: "memory"); SB_; \
          if ((j) + 2 < 32) { DMA_V(TILE((j) + 2), ((j) + 2) % 3); } SB_; \
          PVG(2, vfa_, 0, ls_ += C1[0] + C1[1], if (HN) ma_ = max3f(ma_, N1[0], N1[1])); \
          PVG(2, vfa_, 1, ls_ += C1[2] + C1[3], if (HN) ma_ = max3f(ma_, N1[2], N1[3])); \
          PVG(2, vfa_, 2, ls_ += C1[4] + C1[5], if (HN) ma_ = max3f(ma_, N1[4], N1[5])); \
          PVG(2, vfa_, 3, ls_ += C1[6] + C1[7], if (HN) ma_ = max3f(ma_, N1[6], N1[7])); \
          PVG(3, vfb_, 0, ls_ += C1[8] + C1[9], if (HN) ma_ = max3f(ma_, N1[8], N1[9])); \
          PVG(3, vfb_, 1, ls_ += C1[10] + C1[11], if (HN) ma_ = max3f(ma_, N1[10], N1[11])); \
          PVG(3, vfb_, 2, ls_ += C1[12] + C1[13], if (HN) ma_ = max3f(ma_, N1[12], N1[13])); \
          PVG(3, vfb_, 3, ls_ += C1[14] + C1[15], if (HN) ma_ = max3f(ma_, N1[14], N1[15])); \
          l += ls_; if (HN) RMN = xor32_max(ma_) + NCST; } \
        __builtin_amdgcn_s_setprio(0); \
        if ((j) < 29) asm volatile("s_waitcnt vmcnt(4) lgkmcnt(0)\n\ts_barrier" ::: "memory"); \
        else asm volatile("s_waitcnt vmcnt(0) lgkmcnt(0)\n\ts_barrier" ::: "memory"); \
    } while (0)

    asm volatile("s_waitcnt vmcnt(4)\n\ts_barrier" ::: "memory");
    float rmA = 0.f, rmB = 0.f;
    { bf16x8 kf0_[8]; bf16x8 qx0_; ATT_SIDE(qx0_, cstA, diagA, 0); ATT_KREAD(kf0_, 0); ATT_QKM(A0, A1, kf0_, qx0_);
      float rm_; ATT_ROWMAX(rm_, A0, A1); rmA = xor32_max(rm_) + cstA; }
    asm volatile("s_waitcnt lgkmcnt(0)\n\ts_barrier" ::: "memory");
    if (mp == 1) asm volatile("s_barrier" ::: "memory");
#pragma unroll 1
    for (int jj = 0; jj < 30; jj += 2) {
        ATT_STEP(A0, A1, cstA, diagA, rmA, B0, B1, cstB, diagB, rmB, jj, 1);
        ATT_STEP(B0, B1, cstB, diagB, rmB, A0, A1, cstA, diagA, rmA, jj + 1, 1);
    }
    ATT_STEP(A0, A1, cstA, diagA, rmA, B0, B1, cstB, diagB, rmB, 30, 1);
    ATT_STEP(B0, B1, cstB, diagB, rmB, A0, A1, cstA, diagA, rmA, 31, 0);
    if (mp == 0) asm volatile("s_barrier" ::: "memory");
#undef ATT_STEP
#undef SB_
#undef EXPCH
#undef VREAD
#undef PVG
#undef ATT_QKM
#undef ATT_KREAD
#undef ATT_SIDE
#undef ATT_ROWMAX
#undef DMA_K
#undef DMA_V
#undef TILE
    const int fr_row = 16 * mp + (lane >> 4), fr_col = 4 * (lane & 15);
    u32x2 zA[4], zB[4];
    {
        const bf16_t* zp = szb + (size_t)(b * SEQ + T0 + fr_row) * DM + h * 128 + fr_col;
#pragma unroll
        for (int i = 0; i < 4; ++i) { zA[i] = *(const u32x2*)(zp + (size_t)(4 * i) * DM); zB[i] = *(const u32x2*)(zp + (size_t)(4 * i) * DM + 64); }
    }
    l = xor32_sum(l);
    if (hi == 0) wsf[32 + r32] = l;
    asm volatile("s_waitcnt lgkmcnt(0)" ::: "memory");
    LAS float* xch = (LAS float*)(lds + ATT_X) + wid * 4096;
    const float msc = mp == 0 ? 1.0f : -lam;
#pragma unroll
    for (int r = 0; r < 16; ++r) {
        const float rl = __builtin_amdgcn_rcpf(wsf[32 + crow(r, hi)]) * msc;
#pragma unroll
        for (int d0 = 0; d0 < 4; ++d0) xch[crow(r, hi) * 128 + 32 * d0 + r32] = o[d0][r] * rl;
    }
    asm volatile("s_waitcnt lgkmcnt(0)\n\ts_barrier" ::: "memory");
    {
        const LAS float* xa = (const LAS float*)(lds + ATT_X) + wq * 4096, * xb_ = xa + 4 * 4096;
        bf16_t* op = o_out + (size_t)(b * SEQ + T0 + fr_row) * DM + h * 128 + fr_col;
        const f32x4 gA = *(const f32x4*)(subln_g + fr_col) * (1.0f - LAMBDA_INIT), gB = *(const f32x4*)(subln_g + 64 + fr_col) * (1.0f - LAMBDA_INIT);
#pragma unroll
        for (int i = 0; i < 4; ++i) {
            const int ro = (fr_row + 4 * i) * 128 + fr_col;
            const f32x4 ya = *(const LAS f32x4*)(xa + ro) + *(const LAS f32x4*)(xb_ + ro), yb = *(const LAS f32x4*)(xa + ro + 64) + *(const LAS f32x4*)(xb_ + ro + 64);
            float ss = (ya[0] * ya[0] + ya[1] * ya[1]) + (ya[2] * ya[2] + ya[3] * ya[3]) + (yb[0] * yb[0] + yb[1] * yb[1]) + (yb[2] * yb[2] + yb[3] * yb[3]);
            ss = row16_sum(ss);
            const float rs = __builtin_amdgcn_rsqf(ss * (1.0f / 128.0f) + RMS_EPS);
            const f32x4 za = (f32x4){bf_lo(zA[i].x), bf_hi(zA[i].x), bf_lo(zA[i].y), bf_hi(zA[i].y)}, zb = (f32x4){bf_lo(zB[i].x), bf_hi(zB[i].x), bf_lo(zB[i].y), bf_hi(zB[i].y)};
            const f32x4 va = ya * rs * gA * za, vb = yb * rs * gB * zb;
            u32x2 wa, wb; wa.x = pk2(va[0], va[1]); wa.y = pk2(va[2], va[3]); wb.x = pk2(vb[0], vb[1]); wb.y = pk2(vb[2], vb[3]);
            *(u32x2*)(op + (size_t)(4 * i) * DM) = wa; *(u32x2*)(op + (size_t)(4 * i) * DM + 64) = wb;
        }
    }
}

__global__ void __launch_bounds__(512, 2) fwd_mega(Args a) {
    extern __shared__ __attribute__((aligned(16))) unsigned char lds_raw[];
    LAS unsigned char* lds = (LAS unsigned char*)lds_raw;
    cg::grid_group grid = cg::this_grid();
    const int G = gridDim.x, bx = blockIdx.x;
    const int wave_s = __builtin_amdgcn_readfirstlane((int)(threadIdx.x >> 6));
#define FRESH_TID() const int tid_l = fresh_tid(wave_s); const int tid = tid_l, lane = tid & 63; const int wave = __builtin_amdgcn_readfirstlane(tid >> 6); (void)lane; (void)wave
    const int vcu = (G % 8 == 0) ? (bx % 8) * (G / 8) + bx / 8 : bx;
    unsigned char* ws = a.ws;
    bf16_t* Wt = (bf16_t*)(ws + WS_WIN); bf16_t* Wa_t = (bf16_t*)(ws + WS_WA); bf16_t* Wb_t = (bf16_t*)(ws + WS_WB); bf16_t* Wo_t = (bf16_t*)(ws + WS_WOUT);
    bf16_t* Wg_t = (bf16_t*)(ws + WS_WG); bf16_t* Wp_t = (bf16_t*)(ws + WS_WPLE); bf16_t* pb = (bf16_t*)(ws + WS_PB);
    bf16_t* xb = (bf16_t*)(ws + WS_XB); bf16_t* obuf = xb;
    bf16_t* hcu = (bf16_t*)(ws + WS_HCU);
    bf16_t* gap = (bf16_t*)(ws + WS_GAP); bf16_t* rb = gap;
    bf16_t* qbuf = (bf16_t*)(ws + WS_Q); float* rbuf = (float*)(ws + WS_Q); bf16_t* merged = qbuf;
    bf16_t* kbuf = (bf16_t*)(ws + WS_K);
    bf16_t* vT = (bf16_t*)(ws + WS_VT);
    bf16_t* szb = (bf16_t*)(ws + WS_SZB); bf16_t* ple = szb;
    bf16_t* sga = (bf16_t*)a.out; bf16_t* sgb = sga + (size_t)TOK * DM;

    {
        FRESH_TID();
        const int gthreads = G * 512, gtid = vcu * 512 + tid;
        cvt_rows(a.x, xb, (size_t)TOK * DM / 8, gtid, gthreads);
        LAS float* scr = (LAS float*)(lds + wave * 16384);
        const int gw = vcu * 8 + wave, NGW = G * 8;
        constexpr int I_IN = 16 * 320, I_SQ = 16 * 32, I_PLE = 4 * 32, NITEMS = I_IN + 4 * I_SQ + I_PLE;
        for (int it = gw; it < NITEMS; it += NGW) {
            int r = it;
            if (r < I_IN) { const int kb = r / 320, nb = r % 320; transpose_item(a.w_in, 1024, 10240, Wt, 64 * kb, win_colmap(32 * nb), 32 * nb, scr, lane); continue; } r -= I_IN;
            if (r < 4 * I_SQ) { const int w = r / I_SQ, rr = r % I_SQ, kb = rr / 32, nb = rr % 32;
                const float* src = w == 0 ? a.w_proj_a : w == 1 ? a.w_proj_b : w == 2 ? a.w_out : a.w_ple_gate;
                bf16_t* dst = w == 0 ? Wa_t : w == 1 ? Wb_t : w == 2 ? Wo_t : Wg_t;
                transpose_item(src, 1024, 1024, dst, 64 * kb, 32 * nb, 32 * nb, scr, lane); continue; } r -= 4 * I_SQ;
            { const int kb = r / 32, nb = r % 32; transpose_item(a.w_ple, 256, 1024, Wp_t, 64 * kb, 32 * nb, 32 * nb, scr, lane); }
        }
    }
    grid.sync();

#ifndef P1_REP
#define P1_REP 1
#endif
#pragma unroll 1
    for (int rep1 = 0; rep1 < P1_REP; ++rep1) {
#if !defined(ONLY_G) || ONLY_G == 1
    {
        Gemm g{xb, Wt, TOK, NMAIN, DM, nullptr, nullptr}; StaticOrder S; S.init(TOK, NMAIN, G, bx);
        EpiProj E{hcu, gap, qbuf, kbuf, szb, sga, sgb};
        gemm_phase<EpiProj, StaticOrder, true, true>(lds, g, S, E, wave_s);
    }
#endif
#if !defined(ONLY_G) || ONLY_G == 2
    {
        Gemm g{Wt + (size_t)NMAIN * DM, xb, 1024, TOK, DM, nullptr, nullptr}; StaticOrder S; S.init(1024, TOK, G, bx);
        EpiVT E{vT};
        gemm_phase<EpiVT, StaticOrder, true, true>(lds, g, S, E, wave_s);
    }
#endif
    }
    grid.sync();

#define PANEL_SEAM() do { asm volatile("s_waitcnt vmcnt(0)" ::: "memory"); __syncthreads(); __builtin_amdgcn_fence(__ATOMIC_ACQUIRE, "agent"); } while (0)
    float lam;
    { FRESH_TID();
      const float s1 = wave_sum(a.lq1[lane] * a.lk1[lane]), s2 = wave_sum(a.lq2[lane] * a.lk2[lane]);
      lam = __builtin_bit_cast(float, __builtin_amdgcn_readfirstlane(__builtin_bit_cast(int, __expf(s1) - __expf(s2) + LAMBDA_INIT))); }
#pragma unroll 1
    for (int panel = vcu; panel < TOK / BM; panel += G) {
        {
            FRESH_TID();
            const int t0 = panel * BM;
            cvt_rows(a.p + (size_t)t0 * PLE, pb + (size_t)t0 * PLE, (size_t)BM * PLE / 8, tid, 512);
            for (int i = tid; i < (BM / 2) * (DM / 8); i += 512) {
                const int t = t0 + 2 * (i >> 7), c8 = (i & 127) * 8, s = t & (SEQ - 1);
                const size_t off = (size_t)t * DM + c8;
                const u32x4 z4 = {0u, 0u, 0u, 0u};
                const u32x4 r1 = *(const u32x4*)(hcu + off), r2 = *(const u32x4*)(hcu + off + DM);
                const u32x4 r0 = s > 0 ? *(const u32x4*)(hcu + off - DM) : z4, r3 = s + 2 < SEQ ? *(const u32x4*)(hcu + off + 2 * DM) : z4;
                const u32x4 g0r = *(const u32x4*)(gap + off), g1r = *(const u32x4*)(gap + off + DM);
                f32x4 h0a, h0b, h1a, h1b, h2a, h2b, h3a, h3b, ga, gb, gc, gd;
                unpack8(r0, h0a, h0b); unpack8(r1, h1a, h1b); unpack8(r2, h2a, h2b); unpack8(r3, h3a, h3b); unpack8(g0r, ga, gb); unpack8(g1r, gc, gd);
                const f32x4 w0a = *(const f32x4*)(a.conv_w + c8), w0b = *(const f32x4*)(a.conv_w + c8 + 4);
                const f32x4 w1a = *(const f32x4*)(a.conv_w + DM + c8), w1b = *(const f32x4*)(a.conv_w + DM + c8 + 4);
                const f32x4 w2a = *(const f32x4*)(a.conv_w + 2 * DM + c8), w2b = *(const f32x4*)(a.conv_w + 2 * DM + c8 + 4);
                const f32x4 cba = *(const f32x4*)(a.conv_b + c8), cbb = *(const f32x4*)(a.conv_b + c8 + 4);
                *(u32x4*)(gap + off) = pack8(ga * (w0a * h0a + w1a * h1a + w2a * h2a + cba), gb * (w0b * h0b + w1b * h1b + w2b * h2b + cbb));
                *(u32x4*)(gap + off + DM) = pack8(gc * (w0a * h1a + w1a * h2a + w2a * h3a + cba), gd * (w0b * h1b + w1b * h2b + w2b * h3b + cbb));
            }
        }
#pragma unroll 1
        for (int un = 0; un < 16; ++un)
            attn_unit(lds, qbuf, kbuf, vT, szb, obuf, a.subln_g, lam, panel >> 3, un >> 1, 2 * (panel & 7) + (un & 1), wave_s);
        PANEL_SEAM();
        const PanelOrder S4{panel, DM / BM};
        { Gemm g{gap, Wa_t, TOK, DM, DM, obuf, Wb_t}; const PanelOrder2 S2{panel, DM / BM}; EpiMerge E{sga, merged}; gemm_phase<EpiMerge, PanelOrder2, true, true>(lds, g, S2, E, wave_s); }
        PANEL_SEAM();
        { Gemm g{merged, Wo_t, TOK, DM, DM, nullptr, nullptr}; EpiRes E{a.x, rbuf, rb}; gemm_phase<EpiRes, PanelOrder, true, true>(lds, g, S4, E, wave_s); }
        { Gemm g{pb, Wp_t, TOK, DM, PLE, nullptr, nullptr}; EpiStore E{ple}; gemm_phase<EpiStore, PanelOrder, true, true>(lds, g, S4, E, wave_s); }
        PANEL_SEAM();
        { Gemm g{rb, Wg_t, TOK, DM, DM, nullptr, nullptr}; EpiPle E{ple}; gemm_phase<EpiPle, PanelOrder, true, true>(lds, g, S4, E, wave_s); }
        PANEL_SEAM();
        {
            FRESH_TID();
            f32x4 gg[4], bb[4];
#pragma unroll
            for (int j = 0; j < 4; ++j) { gg[j] = *((const f32x4*)a.ln_g + lane + 64 * j); bb[j] = *((const f32x4*)a.ln_b + lane + 64 * j); }
#pragma unroll 1
            for (int rr = wave; rr < BM; rr += 8) {
                const int m = panel * BM + rr;
                const u32x2* xr = (const u32x2*)(rb + (size_t)m * DM) + lane; const u32x2* dr = (const u32x2*)(ple + (size_t)m * DM) + lane;
                f32x4 v[4]; float s_ = 0.f;
#pragma unroll
                for (int j = 0; j < 4; ++j) { const u32x2 a_ = xr[64 * j], d_ = dr[64 * j];
                    v[j] = (f32x4){bf_lo(a_.x) + bf_lo(d_.x), bf_hi(a_.x) + bf_hi(d_.x), bf_lo(a_.y) + bf_lo(d_.y), bf_hi(a_.y) + bf_hi(d_.y)}; s_ += (v[j].x + v[j].y) + (v[j].z + v[j].w); }
                const float mean = wave_sum(s_) * (1.f / DM); float s2 = 0.f;
#pragma unroll
                for (int j = 0; j < 4; ++j) { v[j] = v[j] - mean; s2 += (v[j].x * v[j].x + v[j].y * v[j].y) + (v[j].z * v[j].z + v[j].w * v[j].w); }
                const float rstd = __builtin_amdgcn_rsqf(wave_sum(s2) * (1.f / DM) + LN_EPS);
                f32x4* orow = (f32x4*)(a.out + (size_t)m * DM) + lane;
#pragma unroll
                for (int j = 0; j < 4; ++j) orow[64 * j] = v[j] * rstd * gg[j] + bb[j];
            }
        }
        PANEL_SEAM();
    }
#undef PANEL_SEAM
}

extern "C" void kernel_launch(void* const* d_in, const int* in_sizes, int n_in, void* d_out, int out_size, void* d_ws, size_t ws_size, hipStream_t stream) {
    static int grid = 0;
    if (grid == 0) {
        if (n_in != 17 || in_sizes[0] != TOK * DM || out_size != TOK * DM || ws_size < WS_END) { fprintf(stderr, "kernel_launch: unexpected shapes (n_in %d, in0 %d, out %d, ws %zu)\n", n_in, n_in > 0 ? in_sizes[0] : -1, out_size, ws_size); grid = -1; return; }
        int dev = 0, cus = 0, per_cu = 0;
        (void)hipGetDevice(&dev); (void)hipDeviceGetAttribute(&cus, hipDeviceAttributeMultiprocessorCount, dev);
        if (hipFuncSetAttribute((const void*)fwd_mega, hipFuncAttributeMaxDynamicSharedMemorySize, LDS_BYTES) != hipSuccess) { fprintf(stderr, "kernel_launch: hipFuncSetAttribute failed\n"); grid = -1; return; }
        if (hipOccupancyMaxActiveBlocksPerMultiprocessor(&per_cu, (const void*)fwd_mega, 512, LDS_BYTES) != hipSuccess || per_cu < 1) { fprintf(stderr, "kernel_launch: occupancy query says %d\n", per_cu); per_cu = 1; }
        (void)hipGetLastError();
        grid = cus * per_cu;
    }
    if (grid < 0) return;
    Args a{};
    a.x = (const float*)d_in[0]; a.p = (const float*)d_in[1]; a.w_in = (const float*)d_in[2]; a.conv_w = (const float*)d_in[3]; a.conv_b = (const float*)d_in[4];
    a.w_proj_a = (const float*)d_in[5]; a.lq1 = (const float*)d_in[6]; a.lk1 = (const float*)d_in[7]; a.lq2 = (const float*)d_in[8]; a.lk2 = (const float*)d_in[9];
    a.subln_g = (const float*)d_in[10]; a.w_proj_b = (const float*)d_in[11]; a.w_out = (const float*)d_in[12]; a.w_ple = (const float*)d_in[13]; a.w_ple_gate = (const float*)d_in[14];
    a.ln_g = (const float*)d_in[15]; a.ln_b = (const float*)d_in[16];
    a.out = (float*)d_out; a.ws = (unsigned char*)d_ws;
    void* args[] = {&a};
    hipError_t e = hipLaunchCooperativeKernel((const void*)fwd_mega, dim3(grid), dim3(512), args, LDS_BYTES, stream);
    if (e != hipSuccess) fprintf(stderr, "kernel_launch: cooperative launch failed: %s (grid %d)\n", hipGetErrorString(e), grid);
}
```

```cpp
#include <hip/hip_runtime.h>
#include <cstdio>
#include <cstdint>
__device__ __forceinline__ int fresh_tid(int wave_s) { int l; asm volatile("v_mbcnt_lo_u32_b32 %0, -1, 0\n\tv_mbcnt_hi_u32_b32 %0, -1, %0" : "=v"(l)); return wave_s * 64 + l; }
namespace pg8 {
#define PG8_LAS __attribute__((address_space(3)))
typedef unsigned short bf16_t;
typedef short bf16x8 __attribute__((ext_vector_type(8)));
typedef float f32x4 __attribute__((ext_vector_type(4)));
typedef unsigned u32x4 __attribute__((ext_vector_type(4)));
constexpr int BM = 256, BK = 64, HALF = 128, HTB = HALF * BK * 2  , STAGE_BYTES = 8 * HTB, NXCD = 8, WGM = 8;

__host__ __device__ __forceinline__ int lds_byte(int r, int c) { const int st = (r >> 4) * 2 + (c >> 5), rr = r & 15, cc = c & 31, ob = rr * 64 + cc * 2; return st * 1024 + (ob ^ (((ob >> 9) & 1) << 5)); }
__host__ __device__ __forceinline__ void stage_rc(int b, int& R, int& C) { const int st = b / 1024, sb = b % 1024, swz = sb ^ (((sb >> 9) & 1) << 5); R = (st >> 1) * 16 + swz / 64; C = (st & 1) * 32 + (swz % 64) / 2; }
__host__ __device__ __forceinline__ int perm32(int rho) { const int n = rho >> 4, i = rho & 15; return 8 * (i >> 2) + 4 * n + (i & 3); }

struct Unit { int pm, pn, sel; };
struct Gemm { const bf16_t* A; const bf16_t* Bt; int M, N, K; const bf16_t* A2; const bf16_t* Bt2; };

struct StaticOrder {
    int nM, nN, nwg, G, c;
    __host__ __device__ void init(int M, int N, int G_, int c_) { nM = M / BM; nN = N / BM; nwg = nM * nN; G = G_; c = c_; }
    __host__ __device__ bool next(int i, Unit& u) const {
        const long L = (long)i * G + c; if (L >= nwg) return false;
        int wgid = (int)L; { const int q = nwg / NXCD, r = nwg % NXCD, xcd = wgid % NXCD, off = wgid / NXCD; wgid = (xcd < r ? xcd * (q + 1) : r * (q + 1) + (xcd - r) * q) + off; }
        const int nig = WGM * nN, gid = wgid / nig, fm = gid * WGM, gsz = (nM - fm) < WGM ? (nM - fm) : WGM;
        u.pm = fm + ((wgid % nig) % gsz); u.pn = (wgid % nig) / gsz; return true;
    }
    __device__ __forceinline__ void a_ready(const Unit&) const {}
    __device__ __forceinline__ void done(const Unit&) const {}
};

__device__ __forceinline__ unsigned cvt_pk_bf16(float lo, float hi) { unsigned r; asm volatile("v_cvt_pk_bf16_f32 %0, %1, %2" : "=v"(r) : "v"(lo), "v"(hi)); return r; }
template <class Epi, class Sched, bool ALIGN_EPI = false, bool SP2 = false>
__device__ __forceinline__ void gemm_phase(PG8_LAS unsigned char* lds, const Gemm g, const Sched& S, const Epi& E, int wave_s) {
    int tid_ = fresh_tid(wave_s);
    const int tid = tid_, wid = __builtin_amdgcn_readfirstlane(tid >> 6), lane = tid & 63, wr = wid >> 2, wc = wid & 3, fr = lane & 15, fq = lane >> 4;
    const int K = g.K, nt = K / BK;
    unsigned voffA[2], voffB[2];
#pragma unroll
    for (int i = 0; i < 2; ++i) { int R, C; stage_rc(tid * 16 + i * 8192, R, C); const int Rb = Epi::PERM ? ((R & ~31) + perm32(R & 31)) : R;
        voffA[i] = (unsigned)(R * K + C) * 2u; voffB[i] = (unsigned)(Rb * K + C) * 2u; }
    const size_t kstep = (size_t)(BK * 2);
    const size_t hstep = (size_t)HALF * K * 2;
    const size_t tstep = 2 * hstep;
    const unsigned ldsw = (unsigned)wid * 1024u;
    const int aoff = lds_byte(wr * 64 + fr, fq * 8), boff = lds_byte(wc * 32 + fr, fq * 8);
#define PG8_SA(b, h) (((b) * 2 + (h)) * HTB)
#define PG8_SB(b, h) ((4 + (b) * 2 + (h)) * HTB)
#define PG8_STAGE(bufoff, gbase, voff) do { _Pragma("unroll") for (int _i = 0; _i < 2; ++_i) \
        __builtin_amdgcn_global_load_lds((const unsigned*)((const char*)(gbase) + (voff)[_i]), (PG8_LAS unsigned*)(lds + (bufoff) + ldsw + _i * 8192), 16, 0, 0); } while (0)
#define PG8_LDA(dst, b, h) do { _Pragma("unroll") for (int m = 0; m < 4; ++m) _Pragma("unroll") for (int k = 0; k < 2; ++k) dst[m][k] = *(const PG8_LAS bf16x8*)(lds + PG8_SA(b, h) + aoff + m * 2048 + k * 1024); } while (0)
#define PG8_LDB(dst, b, h) do { _Pragma("unroll") for (int n = 0; n < 2; ++n) _Pragma("unroll") for (int k = 0; k < 2; ++k) dst[n][k] = *(const PG8_LAS bf16x8*)(lds + PG8_SB(b, h) + boff + n * 2048 + k * 1024); } while (0)
#define PG8_MMA(ai, bj, At, Bt) do { __builtin_amdgcn_s_setprio(1); _Pragma("unroll") for (int m = 0; m < 4; ++m) _Pragma("unroll") for (int n = 0; n < 2; ++n) _Pragma("unroll") for (int k = 0; k < 2; ++k) \
        acc[ai][bj][m][n] = __builtin_amdgcn_mfma_f32_16x16x32_bf16(Bt[n][k], At[m][k], acc[ai][bj][m][n], 0, 0, 0); __builtin_amdgcn_s_setprio(0); } while (0)
#define PG8_WAIT_V(n) asm volatile("s_waitcnt vmcnt(" #n ")" ::: "memory")
#define PG8_WAIT_L(n) asm volatile("s_waitcnt lgkmcnt(" #n ")" ::: "memory")
#define PG8_BAR __builtin_amdgcn_s_barrier()
#define PG8_SCHED __builtin_amdgcn_sched_barrier(0)
    Unit cur, nxt; int ui = 0;
    if (!S.next(0, cur)) return;
    f32x4 acc[2][2][4][2];
#pragma unroll
    for (int a = 0; a < 2; ++a)
#pragma unroll
        for (int b = 0; b < 2; ++b)
#pragma unroll
            for (int m = 0; m < 4; ++m)
#pragma unroll
                for (int n = 0; n < 2; ++n) acc[a][b][m][n] = (f32x4){0.f, 0.f, 0.f, 0.f};
    bf16x8 At[4][2], B0[2][2], B1[2][2];
    const char* cA; const char* cB;
    if constexpr (Epi::FUSED2) { cA = (const char*)(cur.sel ? g.A2 : g.A) + (size_t)cur.pm * tstep; cB = (const char*)(cur.sel ? g.Bt2 : g.Bt) + (size_t)cur.pn * tstep; }
    else { cA = (const char*)g.A + (size_t)cur.pm * tstep; cB = (const char*)g.Bt + (size_t)cur.pn * tstep; }
    S.a_ready(cur);
    if constexpr (SP2) {
        PG8_STAGE(PG8_SB(0, 0), cB, voffB); PG8_STAGE(PG8_SB(0, 1), cB + hstep, voffB); PG8_STAGE(PG8_SA(0, 0), cA, voffA); PG8_STAGE(PG8_SA(0, 1), cA + hstep, voffA);
        if (wr == 1) PG8_BAR;
        PG8_WAIT_V(2); PG8_BAR;
        PG8_STAGE(PG8_SB(1, 0), cB + kstep, voffB); PG8_STAGE(PG8_SA(1, 0), cA + kstep, voffA); PG8_STAGE(PG8_SB(1, 1), cB + hstep + kstep, voffB);
        PG8_WAIT_V(6); PG8_BAR;
    } else {
        PG8_STAGE(PG8_SB(0, 0), cB, voffB); PG8_STAGE(PG8_SA(0, 0), cA, voffA); PG8_STAGE(PG8_SB(0, 1), cB + hstep, voffB); PG8_STAGE(PG8_SA(0, 1), cA + hstep, voffA);
        if (wr == 1) PG8_BAR;
        PG8_WAIT_V(4); PG8_BAR;
        PG8_STAGE(PG8_SB(1, 0), cB + kstep, voffB); PG8_STAGE(PG8_SA(1, 0), cA + kstep, voffA); PG8_STAGE(PG8_SB(1, 1), cB + hstep + kstep, voffB);
        PG8_WAIT_V(6); PG8_BAR;
    }
    for (;;) {
        const bool has_next = S.next(ui + 1, nxt);
        const char* nA; const char* nB;
        if constexpr (Epi::FUSED2) { nA = has_next ? (const char*)(nxt.sel ? g.A2 : g.A) + (size_t)nxt.pm * tstep : cA; nB = has_next ? (const char*)(nxt.sel ? g.Bt2 : g.Bt) + (size_t)nxt.pn * tstep : cB; }
        else { nA = has_next ? (const char*)g.A + (size_t)nxt.pm * tstep : cA; nB = has_next ? (const char*)g.Bt + (size_t)nxt.pn * tstep : cB; }
#pragma unroll 1
        for (int t = 0; t < nt; t += 2) {
            const bool last = (t == nt - 2);
            const char* a1 = cA + (size_t)(t + 1) * kstep;
            const char* a2 = last ? nA : cA + (size_t)(t + 2) * kstep; const char* b2 = last ? nB : cB + (size_t)(t + 2) * kstep;
            const char* a3 = a2 + kstep; const char* b3 = b2 + kstep;
            if (last && has_next) S.a_ready(nxt);
            if constexpr (SP2) {
            PG8_LDB(B0, 0, 0); PG8_LDB(B1, 0, 1); PG8_SCHED; PG8_LDA(At, 0, 0); PG8_STAGE(PG8_SA(1, 1), a1 + hstep, voffA);
            PG8_WAIT_V(8); PG8_WAIT_L(0); PG8_BAR; PG8_MMA(0, 0, At, B0); PG8_MMA(0, 1, At, B1); PG8_BAR; PG8_SCHED;
            PG8_LDA(At, 0, 1); PG8_STAGE(PG8_SB(0, 0), b2, voffB); PG8_STAGE(PG8_SB(0, 1), b2 + hstep, voffB); PG8_STAGE(PG8_SA(0, 0), a2, voffA);
            PG8_WAIT_V(8); PG8_WAIT_L(0); PG8_BAR; PG8_MMA(1, 0, At, B0); PG8_MMA(1, 1, At, B1); PG8_BAR; PG8_SCHED;
            PG8_LDB(B0, 1, 0); PG8_LDB(B1, 1, 1); PG8_SCHED; PG8_LDA(At, 1, 0); PG8_STAGE(PG8_SA(0, 1), a2 + hstep, voffA);
            PG8_WAIT_V(8); PG8_WAIT_L(0); PG8_BAR; PG8_MMA(0, 0, At, B0); PG8_MMA(0, 1, At, B1); PG8_BAR; PG8_SCHED;
            PG8_LDA(At, 1, 1); PG8_STAGE(PG8_SB(1, 0), b3, voffB); PG8_STAGE(PG8_SB(1, 1), b3 + hstep, voffB); PG8_STAGE(PG8_SA(1, 0), a3, voffA);
            PG8_WAIT_V(8); PG8_WAIT_L(0); PG8_BAR; PG8_MMA(1, 0, At, B0); PG8_MMA(1, 1, At, B1); PG8_BAR; PG8_SCHED;
            } else {
            PG8_LDB(B0, 0, 0); PG8_SCHED; PG8_LDA(At, 0, 0); PG8_STAGE(PG8_SA(1, 1), a1 + hstep, voffA);
            PG8_WAIT_L(8); PG8_BAR; PG8_WAIT_L(0); PG8_MMA(0, 0, At, B0); PG8_BAR; PG8_SCHED;
            PG8_LDB(B1, 0, 1); PG8_STAGE(PG8_SB(0, 0), b2, voffB);
            PG8_BAR; PG8_WAIT_L(0); PG8_MMA(0, 1, At, B1); PG8_BAR;
            PG8_LDA(At, 0, 1); PG8_STAGE(PG8_SA(0, 0), a2, voffA);
            PG8_BAR; PG8_WAIT_L(0); PG8_MMA(1, 0, At, B0); PG8_BAR; PG8_SCHED;
            PG8_STAGE(PG8_SB(0, 1), b2 + hstep, voffB);
            PG8_WAIT_V(6); PG8_BAR; PG8_MMA(1, 1, At, B1); PG8_BAR;
            PG8_LDB(B0, 1, 0); PG8_SCHED; PG8_LDA(At, 1, 0); PG8_STAGE(PG8_SA(0, 1), a2 + hstep, voffA);
            PG8_WAIT_L(8); PG8_BAR; PG8_WAIT_L(0); PG8_MMA(0, 0, At, B0); PG8_BAR; PG8_SCHED;
            PG8_LDB(B1, 1, 1); PG8_STAGE(PG8_SB(1, 0), b3, voffB);
            PG8_BAR; PG8_WAIT_L(0); PG8_MMA(0, 1, At, B1); PG8_BAR;
            PG8_LDA(At, 1, 1); PG8_STAGE(PG8_SA(1, 0), a3, voffA);
            PG8_BAR; PG8_WAIT_L(0); PG8_MMA(1, 0, At, B0); PG8_BAR; PG8_SCHED;
            PG8_STAGE(PG8_SB(1, 1), b3 + hstep, voffB);
            PG8_WAIT_V(6); PG8_BAR; PG8_MMA(1, 1, At, B1); PG8_BAR;
            }
        }
        if constexpr (ALIGN_EPI) { if (wr == 0) PG8_BAR; }
        if constexpr (!Epi::AFTER_DRAIN) { E(acc, cur, wr, wc, fr, fq); S.done(cur); }
        if (!has_next) break;
        bool keep_acc = false; if constexpr (Epi::FUSED2) keep_acc = (nxt.sel != 0);
        if (!keep_acc) {
#pragma unroll
        for (int a = 0; a < 2; ++a)
#pragma unroll
            for (int b = 0; b < 2; ++b)
#pragma unroll
                for (int m = 0; m < 4; ++m)
#pragma unroll
                    for (int n = 0; n < 2; ++n) acc[a][b][m][n] = (f32x4){0.f, 0.f, 0.f, 0.f};
        }
        cur = nxt; cA = nA; cB = nB; ++ui;
        if constexpr (ALIGN_EPI) { if (wr == 1) PG8_BAR; }
    }
    PG8_WAIT_V(0);
    if constexpr (!ALIGN_EPI) { if (wr == 0) PG8_BAR; }
    PG8_BAR;
    if constexpr (Epi::AFTER_DRAIN) { E.fused(acc, cur, wr, wc, fr, fq, lds, wid, lane); S.done(cur); }
#undef PG8_SA
#undef PG8_SB
#undef PG8_STAGE
#undef PG8_LDA
#undef PG8_LDB
#undef PG8_MMA
#undef PG8_WAIT_V
#undef PG8_WAIT_L
#undef PG8_BAR
#undef PG8_SCHED
}
}

#include <hip/hip_cooperative_groups.h>
namespace cg = cooperative_groups;
using namespace pg8;
#define LAS __attribute__((address_space(3)))
typedef float f32x16 __attribute__((ext_vector_type(16)));
typedef unsigned u32x2 __attribute__((ext_vector_type(2)));

constexpr int TOK = 65536, DM = 1024, SEQ = 2048, NB = 32, NH = 8, PLE = 256;
constexpr int NMAIN = 9216;
constexpr float LOG2E = 1.4426950408889634f;
constexpr float QSCALE = 0.125f * LOG2E;
constexpr float ALPHA = 1.189207115002721f;
constexpr float LAMBDA_INIT = 0.2f;
constexpr float LN_EPS = 1e-5f, RMS_EPS = 1e-5f;

constexpr size_t MiB = 1u << 20, SLOT = 128 * MiB;
constexpr size_t WS_WIN = 0, WS_WA = 20 * MiB, WS_WB = 22 * MiB, WS_WOUT = 24 * MiB, WS_WG = 26 * MiB, WS_WPLE = 28 * MiB, WS_PB = 32 * MiB;
constexpr size_t WS_XB = 1 * SLOT;
constexpr size_t WS_HCU = 2 * SLOT;
constexpr size_t WS_GAP = 3 * SLOT;
constexpr size_t WS_Q = 4 * SLOT;
constexpr size_t WS_K = 5 * SLOT;
constexpr size_t WS_VT = 6 * SLOT;
constexpr size_t WS_SZB = 7 * SLOT;
constexpr size_t WS_END = 8 * SLOT;

constexpr int LDS_BYTES = 147456;

struct Args {
    const float* x; const float* p; const float* w_in; const float* conv_w; const float* conv_b; const float* w_proj_a;
    const float* lq1; const float* lk1; const float* lq2; const float* lk2; const float* subln_g; const float* w_proj_b;
    const float* w_out; const float* w_ple; const float* w_ple_gate; const float* ln_g; const float* ln_b;
    float* out; unsigned char* ws;
};

__device__ __forceinline__ unsigned f2bf(float f) { unsigned u = __builtin_bit_cast(unsigned, f); return (u + 0x7fffu + ((u >> 16) & 1u)) >> 16; }
__device__ __forceinline__ unsigned pk2(float lo, float hi) { return cvt_pk_bf16(lo, hi); }
__device__ __forceinline__ float bf_lo(unsigned u) { return __builtin_bit_cast(float, u << 16); }
__device__ __forceinline__ float bf_hi(unsigned u) { return __builtin_bit_cast(float, u & 0xffff0000u); }
__device__ __forceinline__ float sigmoidf_(float v) { return __builtin_amdgcn_rcpf(1.0f + __builtin_amdgcn_exp2f(-v * LOG2E)); }
__device__ __forceinline__ f32x4 sig4(f32x4 v) { return (f32x4){sigmoidf_(v[0]), sigmoidf_(v[1]), sigmoidf_(v[2]), sigmoidf_(v[3])}; }
__device__ __forceinline__ u32x4 pack8(f32x4 a, f32x4 b) { u32x4 w; w.x = pk2(a[0], a[1]); w.y = pk2(a[2], a[3]); w.z = pk2(b[0], b[1]); w.w = pk2(b[2], b[3]); return w; }
__device__ __forceinline__ void unpack8(u32x4 w, f32x4& a, f32x4& b) { a = (f32x4){bf_lo(w.x), bf_hi(w.x), bf_lo(w.y), bf_hi(w.y)}; b = (f32x4){bf_lo(w.z), bf_hi(w.z), bf_lo(w.w), bf_hi(w.w)}; }

struct PanelOrder {
    int panel, nN;
    __host__ __device__ bool next(int i, Unit& u) const { if (i >= nN) return false; u.pm = panel; u.pn = i; u.sel = 0; return true; }
    __device__ __forceinline__ void a_ready(const Unit&) const {}
    __device__ __forceinline__ void done(const Unit&) const {}
};
struct EpiProj {
    static constexpr bool PERM = true, AFTER_DRAIN = false, FUSED2 = false;
    bf16_t *hcu, *gap, *q, *k, *szb, *sga, *sgb;
    __device__ __forceinline__ void operator()(const f32x4 (&acc)[2][2][4][2], const Unit& u, int wr, int wc, int fr, int fq) const {
        const int row0 = u.pm * BM + wr * 64 + fr;
        if (u.pn < 16) {
            bf16_t* base = (wc < 2) ? hcu : gap;
            const int col = u.pn * 64 + (wc & 1) * 32 + 8 * fq;
#pragma unroll
            for (int ai = 0; ai < 2; ++ai)
#pragma unroll
                for (int m = 0; m < 4; ++m) {
                    f32x4 a0 = acc[ai][0][m][0], a1 = acc[ai][0][m][1], b0 = acc[ai][1][m][0], b1 = acc[ai][1][m][1];
                    if (wc >= 2) { b0 = b0 * sig4(b0); b1 = b1 * sig4(b1); }
                    *(u32x4*)(base + (size_t)(row0 + ai * HALF + m * 16) * DM + col) = pack8(a0 * b0, a1 * b1);
                }
        } else {
            const int t = (u.pn - 16) >> 2;
            bf16_t* base = sga;
            if (t < 3) base = q + (size_t)(t == 2 ? 3 : t) * (SLOT / 2);
            const int col = ((u.pn - 16) & 3) * 256 + wc * 32 + 8 * fq;
#pragma unroll
            for (int ai = 0; ai < 2; ++ai)
#pragma unroll
                for (int m = 0; m < 4; ++m)
#pragma unroll
                    for (int bj = 0; bj < 2; ++bj) {
                        f32x4 v0 = acc[ai][bj][m][0], v1 = acc[ai][bj][m][1];
                        if (t == 0) { v0 = v0 * QSCALE; v1 = v1 * QSCALE; }
                        else if (t == 2) { v0 = v0 * sig4(v0); v1 = v1 * sig4(v1); }
                        else if (t >= 3) { v0 = sig4(v0); v1 = sig4(v1); }
                        const unsigned row = (unsigned)(row0 + ai * HALF + m * 16), cc = (unsigned)(col + bj * HALF);
                        unsigned off = row * DM + cc;
                        if (t >= 3) off = (row >> 8) * 524288u + (unsigned)(t - 3) * 262144u + (row & 255u) * DM + cc;
                        if (t == 1) off = (((((row >> 11) * 8u + (cc >> 7)) * 2u + ((cc >> 6) & 1u)) * 32u + ((row & 2047u) >> 6)) * 64u + (row & 63u)) * 64u + (cc & 63u);
                        *(u32x4*)(base + off) = pack8(v0, v1);
                    }
        }
    }
};
struct EpiVT {
    static constexpr bool PERM = true, AFTER_DRAIN = false, FUSED2 = false;
    bf16_t* vT;
    __device__ __forceinline__ void operator()(const f32x4 (&acc)[2][2][4][2], const Unit& u, int wr, int wc, int fr, int fq) const {
        const int row0 = u.pm * BM + wr * 64 + fr;
        const int col0 = u.pn * BM + wc * 32 + 8 * fq;
        const int b = col0 >> 11;
#pragma unroll
        for (int ai = 0; ai < 2; ++ai)
#pragma unroll
            for (int m = 0; m < 4; ++m)
#pragma unroll
                for (int bj = 0; bj < 2; ++bj) {
                    const int row = row0 + ai * HALF + m * 16, s = (col0 & 2047) + bj * HALF;
                    *(u32x4*)(vT + ((size_t)(((b * 8 + (row >> 7)) * 32 + (s >> 6)) * 128 + (row & 127))) * 64 + (s & 63)) = pack8(acc[ai][bj][m][0], acc[ai][bj][m][1]);
                }
    }
};
struct EpiStore {
    static constexpr bool PERM = true, AFTER_DRAIN = false, FUSED2 = false;
    bf16_t* O; static constexpr int ldc = DM;
    __device__ __forceinline__ void operator()(const f32x4 (&acc)[2][2][4][2], const Unit& u, int wr, int wc, int fr, int fq) const {
        const int row0 = u.pm * BM + wr * 64 + fr, col0 = u.pn * BM + wc * 32 + 8 * fq;
#pragma unroll
        for (int ai = 0; ai < 2; ++ai)
#pragma unroll
            for (int m = 0; m < 4; ++m)
#pragma unroll
                for (int bj = 0; bj < 2; ++bj)
                    *(u32x4*)(O + (size_t)(row0 + ai * HALF + m * 16) * ldc + col0 + bj * HALF) = pack8(acc[ai][bj][m][0], acc[ai][bj][m][1]);
    }
};
template <int MODE> struct EpiGate {
    static constexpr bool PERM = true, AFTER_DRAIN = false, FUSED2 = false;
    const bf16_t* gate; bf16_t* O;
    __device__ __forceinline__ void operator()(const f32x4 (&acc)[2][2][4][2], const Unit& u, int wr, int wc, int fr, int fq) const {
        const int row0 = u.pm * BM + wr * 64 + fr, col0 = u.pn * BM + wc * 32 + 8 * fq;
        const unsigned gbase = (unsigned)u.pm * 524288u + (unsigned)MODE * 262144u + (unsigned)(wr * 64 + fr) * DM + (unsigned)col0;
        const unsigned obase = (unsigned)row0 * DM + (unsigned)col0;
        u32x4 gv[2][2][2], tv[2][2][2];
#define EG_LOAD(q) do { _Pragma("unroll") for (int ml = 0; ml < 2; ++ml) _Pragma("unroll") for (int bj = 0; bj < 2; ++bj) { const int ai = (q) >> 1, m = 2 * ((q) & 1) + ml; \
            gv[(q) & 1][ml][bj] = *(const u32x4*)(gate + gbase + (unsigned)(ai * HALF + m * 16) * DM + bj * HALF); \
            if (MODE == 1) tv[(q) & 1][ml][bj] = *(const u32x4*)(O + (obase + (unsigned)((ai * HALF + m * 16) * DM + bj * HALF))); } } while (0)
#define EG_PROC(q) do { _Pragma("unroll") for (int ml = 0; ml < 2; ++ml) _Pragma("unroll") for (int bj = 0; bj < 2; ++bj) { const int ai = (q) >> 1, m = 2 * ((q) & 1) + ml; \
            f32x4 g0, g1; unpack8(gv[(q) & 1][ml][bj], g0, g1); \
            f32x4 v0 = g0 * acc[ai][bj][m][0], v1 = g1 * acc[ai][bj][m][1]; \
            if (MODE == 1) { f32x4 t0, t1; unpack8(tv[(q) & 1][ml][bj], t0, t1); v0 = v0 + t0; v1 = v1 + t1; } \
            *(u32x4*)(O + (obase + (unsigned)((ai * HALF + m * 16) * DM + bj * HALF))) = pack8(v0, v1); } } while (0)
        EG_LOAD(0); EG_LOAD(1); EG_PROC(0); EG_LOAD(2); EG_PROC(1); EG_LOAD(3); EG_PROC(2); EG_PROC(3);
#undef EG_LOAD
#undef EG_PROC
    }
};
struct EpiMerge {
    static constexpr bool PERM = true, AFTER_DRAIN = false, FUSED2 = true;
    const bf16_t* gate; bf16_t* O;
    __device__ __forceinline__ void operator()(f32x4 (&acc)[2][2][4][2], const Unit& u, int wr, int wc, int fr, int fq) const {
        const int row0 = u.pm * BM + wr * 64 + fr, col0 = u.pn * BM + wc * 32 + 8 * fq;
        const unsigned gbase = (unsigned)u.pm * 524288u + (unsigned)(wr * 64 + fr) * DM + (unsigned)col0;
        const unsigned obase = (unsigned)row0 * DM + (unsigned)col0;
        u32x4 ga_[2][2][2], gb_[2][2][2];
#define EM_LOAD(q) do { _Pragma("unroll") for (int ml = 0; ml < 2; ++ml) _Pragma("unroll") for (int bj = 0; bj < 2; ++bj) { const int ai = (q) >> 1, m = 2 * ((q) & 1) + ml; \
            const unsigned go_ = gbase + (unsigned)((ai * HALF + m * 16) * DM + bj * HALF); \
            gb_[(q) & 1][ml][bj] = *(const u32x4*)(gate + go_ + 262144u); if (!u.sel) ga_[(q) & 1][ml][bj] = *(const u32x4*)(gate + go_); } } while (0)
#define EM_PROC(q) do { _Pragma("unroll") for (int ml = 0; ml < 2; ++ml) _Pragma("unroll") for (int bj = 0; bj < 2; ++bj) { const int ai = (q) >> 1, m = 2 * ((q) & 1) + ml; \
            f32x4 b0, b1; unpack8(gb_[(q) & 1][ml][bj], b0, b1); \
            if (!u.sel) { f32x4 a0, a1; unpack8(ga_[(q) & 1][ml][bj], a0, a1); \
                _Pragma("unroll") for (int i = 0; i < 4; ++i) { acc[ai][bj][m][0][i] *= a0[i] * __builtin_amdgcn_rcpf(__builtin_fmaxf(b0[i], 1e-30f)); acc[ai][bj][m][1][i] *= a1[i] * __builtin_amdgcn_rcpf(__builtin_fmaxf(b1[i], 1e-30f)); } } \
            else { *(u32x4*)(O + (obase + (unsigned)((ai * HALF + m * 16) * DM + bj * HALF))) = pack8(acc[ai][bj][m][0] * b0, acc[ai][bj][m][1] * b1); } } } while (0)
        EM_LOAD(0); EM_LOAD(1); EM_PROC(0); EM_LOAD(2); EM_PROC(1); EM_LOAD(3); EM_PROC(2); EM_PROC(3);
#undef EM_LOAD
#undef EM_PROC
    }
};
struct PanelOrder2 {
    int panel, nN;
    __host__ __device__ bool next(int i, Unit& u) const { if (i >= 2 * nN) return false; u.pm = panel; u.pn = i >> 1; u.sel = i & 1; return true; }
    __device__ __forceinline__ void a_ready(const Unit&) const {}
    __device__ __forceinline__ void done(const Unit&) const {}
};
struct EpiRes {
    static constexpr bool PERM = true, AFTER_DRAIN = false, FUSED2 = false;
    const float* x; float* r; bf16_t* rb;
    __device__ __forceinline__ void operator()(const f32x4 (&acc)[2][2][4][2], const Unit& u, int wr, int wc, int fr, int fq) const {
        const int row0 = u.pm * BM + wr * 64 + fr, col0 = u.pn * BM + wc * 32 + 8 * fq;
        const unsigned obase = (unsigned)row0 * DM + (unsigned)col0;
        f32x4 xs[2][2][2][2];
#define ER_LOAD(q) do { _Pragma("unroll") for (int ml = 0; ml < 2; ++ml) _Pragma("unroll") for (int bj = 0; bj < 2; ++bj) { const int ai = (q) >> 1, m = 2 * ((q) & 1) + ml; \
            const unsigned off = obase + (unsigned)((ai * HALF + m * 16) * DM + bj * HALF); \
            xs[(q) & 1][ml][bj][0] = *(const f32x4*)(x + off); xs[(q) & 1][ml][bj][1] = *(const f32x4*)(x + off + 4); } } while (0)
#define ER_PROC(q) do { _Pragma("unroll") for (int ml = 0; ml < 2; ++ml) _Pragma("unroll") for (int bj = 0; bj < 2; ++bj) { const int ai = (q) >> 1, m = 2 * ((q) & 1) + ml; \
            const unsigned off = obase + (unsigned)((ai * HALF + m * 16) * DM + bj * HALF); \
            const f32x4 v0 = xs[(q) & 1][ml][bj][0] * ALPHA + acc[ai][bj][m][0], v1 = xs[(q) & 1][ml][bj][1] * ALPHA + acc[ai][bj][m][1]; \
            *(u32x4*)(rb + off) = pack8(v0, v1); } } while (0)
        ER_LOAD(0); ER_LOAD(1); ER_PROC(0); ER_LOAD(2); ER_PROC(1); ER_LOAD(3); ER_PROC(2); ER_PROC(3);
#undef ER_LOAD
#undef ER_PROC
    }
};
struct EpiPle {
    static constexpr bool PERM = true, AFTER_DRAIN = false, FUSED2 = false;
    bf16_t* ple;
    __device__ __forceinline__ void operator()(const f32x4 (&acc)[2][2][4][2], const Unit& u, int wr, int wc, int fr, int fq) const {
        const int row0 = u.pm * BM + wr * 64 + fr, col0 = u.pn * BM + wc * 32 + 8 * fq;
        const unsigned obase = (unsigned)row0 * DM + (unsigned)col0;
        u32x4 ev[2][2][2];
#define EP_LOAD(q) do { _Pragma("unroll") for (int ml = 0; ml < 2; ++ml) _Pragma("unroll") for (int bj = 0; bj < 2; ++bj) { const int ai = (q) >> 1, m = 2 * ((q) & 1) + ml; \
            ev[(q) & 1][ml][bj] = *(const u32x4*)(ple + (obase + (unsigned)((ai * HALF + m * 16) * DM + bj * HALF))); } } while (0)
#define EP_PROC(q) do { _Pragma("unroll") for (int ml = 0; ml < 2; ++ml) _Pragma("unroll") for (int bj = 0; bj < 2; ++bj) { const int ai = (q) >> 1, m = 2 * ((q) & 1) + ml; \
            f32x4 e0, e1; unpack8(ev[(q) & 1][ml][bj], e0, e1); \
            *(u32x4*)(ple + (obase + (unsigned)((ai * HALF + m * 16) * DM + bj * HALF))) = pack8(sig4(acc[ai][bj][m][0]) * e0, sig4(acc[ai][bj][m][1]) * e1); } } while (0)
        EP_LOAD(0); EP_LOAD(1); EP_PROC(0); EP_LOAD(2); EP_PROC(1); EP_LOAD(3); EP_PROC(2); EP_PROC(3);
#undef EP_LOAD
#undef EP_PROC
    }
};

template <int CTRL> __device__ __forceinline__ float dppf(float v) { return __builtin_bit_cast(float, __builtin_amdgcn_update_dpp(0, __builtin_bit_cast(int, v), CTRL, 0xf, 0xf, true)); }
__device__ __forceinline__ float row16_sum(float v) { v += dppf<0xB1>(v); v += dppf<0x4E>(v); v += dppf<0x141>(v); v += dppf<0x140>(v); return v; }
__device__ __forceinline__ void swap16(float v, float& a, float& b) { a = v; b = v; asm volatile("s_nop 1\n\tv_permlane16_swap_b32 %0, %1\n\ts_nop 1" : "+v"(a), "+v"(b)); }
__device__ __forceinline__ void swap32(float v, float& a, float& b) { a = v; b = v; asm volatile("s_nop 1\n\tv_permlane32_swap_b32 %0, %1\n\ts_nop 1" : "+v"(a), "+v"(b)); }
__device__ __forceinline__ float xor16_sum(float v) { float a, b; swap16(v, a, b); return a + b; }
__device__ __forceinline__ float xor32_sum(float v) { float a, b; swap32(v, a, b); return a + b; }
__device__ __forceinline__ float xor32_max(float v) { float a, b; swap32(v, a, b); return __builtin_fmaxf(a, b); }
__device__ __forceinline__ float wave_sum(float v) { return xor32_sum(xor16_sum(row16_sum(v))); }
__device__ __forceinline__ void transpose_item(const float* W, int K, int N, bf16_t* WT, int k0, int n_src, int n_dst, LAS float* scr, int lane) {
#pragma unroll 8
    for (int i = 0; i < 32; ++i) { const int kk = 2 * i + (lane >> 5); scr[kk * 33 + (lane & 31)] = W[(size_t)(k0 + kk) * N + n_src + (lane & 31)]; }
    asm volatile("s_waitcnt lgkmcnt(0)" ::: "memory");
    const int c = lane & 7;
#pragma unroll
    for (int j = 0; j < 4; ++j) { const int n = (lane >> 3) + 8 * j; const LAS float* s = scr + (8 * c) * 33 + n;
        u32x4 o; o.x = pk2(s[0 * 33], s[1 * 33]); o.y = pk2(s[2 * 33], s[3 * 33]); o.z = pk2(s[4 * 33], s[5 * 33]); o.w = pk2(s[6 * 33], s[7 * 33]);
        *(u32x4*)(WT + (size_t)(n_dst + n) * K + k0 + 8 * c) = o; }
    asm volatile("s_waitcnt lgkmcnt(0)" ::: "memory");
}
__device__ __forceinline__ int win_colmap(int np) {
    if (np < 4096) { const int tile = np >> 8, half = (np >> 7) & 1, c = np & 127, which = c >> 6, ch = 64 * tile + (c & 63);
        const int base = half == 0 ? (which == 0 ? 0 : 2048) : (which == 0 ? 1024 : 3072); return base + ch; }
    if (np < 6144) return np;
    if (np < NMAIN) return np + 1024;
    return 6144 + (np - NMAIN);
}
__device__ __forceinline__ void cvt_rows(const float* src, bf16_t* dst, size_t n8, int gtid, int gthreads) {
    for (size_t i = gtid; i < n8; i += gthreads) {
        const f32x4 a = *(const f32x4*)(src + i * 8), b = *(const f32x4*)(src + i * 8 + 4);
        *(u32x4*)(dst + i * 8) = pack8(a, b);
    }
}

__device__ __forceinline__ int crow(int r, int hi) { return (r & 3) + 8 * (r >> 2) + 4 * hi; }
__device__ __forceinline__ float max3f(float a, float b, float c) { float r; asm("v_max3_f32 %0, %1, %2, %3" : "=v"(r) : "v"(a), "v"(b), "v"(c)); return r; }
constexpr int KSLOT = 16384, VSLOT = 16384, ATT_K = 0, ATT_V = 3 * KSLOT, ATT_X = 0, ATT_WS = 131072;
__device__ __forceinline__ void glds16(const void* g, LAS unsigned char* l) { __builtin_amdgcn_global_load_lds((const unsigned*)g, (LAS unsigned*)l, 16, 0, 0); }

__device__ __forceinline__ void attn_unit(LAS unsigned char* lds, const bf16_t* __restrict__ q, const bf16_t* __restrict__ k, const bf16_t* __restrict__ vT,
                                          const bf16_t* __restrict__ szb, bf16_t* __restrict__ o_out, const float* __restrict__ subln_g, float lam, int b, int h, int qb, int wave_s) {
    int tid_ = fresh_tid(wave_s);
    const int tid = tid_, lane = tid & 63, r32 = lane & 31, hi = lane >> 5; const int wid = __builtin_amdgcn_readfirstlane(tid >> 6);
    const int mp = wid >> 2, wq = wid & 3;
    const float m2 = __builtin_amdgcn_exp2f(-(float)(h + 1)) * LOG2E;
    LAS float* wsf = (LAS float*)(lds + ATT_WS) + wid * 64;
    const int T0 = qb * 128 + wq * 32, tpos = T0 + r32;
    const int krow = (r32 & 0x13) | ((r32 & 4) << 1) | ((r32 & 8) >> 1);
    const int kr = 8 * wid + (lane >> 3);
    const unsigned kgo = (unsigned)((b * 8 + h) * 2 * 32 * 4096 + kr * 64 + (((lane & 7) ^ ((kr >> 1) & 7)) * 8));
    const unsigned vgo = (unsigned)((b * 8 + h) * 32 * 8192 + kr * 64 + (((lane & 7) ^ ((kr >> 1) & 7)) * 8));
    LAS unsigned char* kdst = lds + ATT_K + wid * 1024;
    LAS unsigned char* vdst = lds + ATT_V + wid * 1024;
#define DMA_K(tile, slot) do { const unsigned o_ = kgo + (unsigned)(tile) * 4096; glds16(k + o_, kdst + (slot) * KSLOT); glds16(k + o_ + 32 * 4096, kdst + (slot) * KSLOT + 8192); } while (0)
#define DMA_V(tile, slot) do { const unsigned o_ = vgo + (unsigned)(tile) * 8192; glds16(vT + o_, vdst + (slot) * VSLOT); glds16(vT + o_ + 4096, vdst + (slot) * VSLOT + 8192); } while (0)
#define TILE(j) ((2 * qb + (j)) & 31)
    int koffs[4], voffs[4];
    { const int fk = (krow >> 1) & 7, fv = (r32 >> 1) & 7;
#pragma unroll
      for (int i = 0; i < 4; ++i) { koffs[i] = mp * 8192 + krow * 128 + (((2 * i + hi) ^ fk) << 4); voffs[i] = r32 * 128 + (((2 * i + hi) ^ fv) << 4); } }
    const unsigned m2hi = f2bf(m2), m2lo = f2bf(m2 - __builtin_bit_cast(float, m2hi << 16));
    u32x4 kx0w = {0u, 0u, 0u, 0u}, kx1w = {0u, 0u, 0u, 0u}, qxw = {0u, 0u, 0u, 0u};
    if (hi == 0) {
        const unsigned s0 = f2bf((float)krow), s1 = f2bf((float)(krow + 32)), tr = f2bf((float)r32);
        kx0w.x = (m2hi | (m2lo << 16)) ^ 0x80008000u; kx0w.y = s0 | (s0 << 16);
        kx1w.x = kx0w.x; kx1w.y = s1 | (s1 << 16);
        qxw.x = tr | (tr << 16); qxw.y = m2hi | (m2lo << 16);
    }
    const bf16x8 kx0 = __builtin_bit_cast(bf16x8, kx0w), kx1 = __builtin_bit_cast(bf16x8, kx1w);

    asm volatile("s_waitcnt lgkmcnt(0)\n\ts_barrier" ::: "memory");
    bf16x8 qr[4];
    {
        const bf16_t* qp = q + (size_t)(b * SEQ + tpos) * DM + h * 128 + mp * 64 + hi * 8;
#pragma unroll
        for (int d0 = 0; d0 < 4; ++d0) qr[d0] = *(const bf16x8*)(qp + 16 * d0);
    }
    DMA_K(TILE(0), 0); DMA_K(TILE(1), 1); DMA_V(TILE(0), 0); DMA_K(TILE(2), 2); DMA_V(TILE(1), 1);
    f32x16 o[4];
#pragma unroll
    for (int d0 = 0; d0 < 4; ++d0)
#pragma unroll
        for (int r = 0; r < 16; ++r) o[d0][r] = 0.f;
    float mref = -1e30f, l = 0.f;
    float cstA = 0.f, cstB = 0.f; bool diagA = false, diagB = false;
    f32x16 A0, A1, B0, B1;
    const f32x16 zero16 = {0.f, 0.f, 0.f, 0.f, 0.f, 0.f, 0.f, 0.f, 0.f, 0.f, 0.f, 0.f, 0.f, 0.f, 0.f, 0.f};
#define ATT_SIDE(QX, CST, DIAG, jn) do { \
        const int S0_ = 64 * TILE(jn); u32x4 qs_ = qxw; \
        if (S0_ + 63 <= T0) { CST = -m2 * (float)(T0 - S0_); DIAG = false; } \
        else if (S0_ >= T0 + 31) { CST = -m2 * (float)(S0_ - T0); DIAG = false; qs_.x ^= 0x80008000u; qs_.y ^= 0x80008000u; } \
        else { CST = 0.f; DIAG = true; qs_.x = 0u; qs_.y = 0u; } \
        QX = __builtin_bit_cast(bf16x8, qs_); } while (0)
#define ATT_KREAD(KF, jn) do { const LAS unsigned char* kb_ = lds + ATT_K + ((jn) % 3) * KSLOT; \
        _Pragma("unroll") for (int d0 = 0; d0 < 4; ++d0) { KF[2 * d0] = *(const LAS bf16x8*)(kb_ + koffs[d0]); KF[2 * d0 + 1] = *(const LAS bf16x8*)(kb_ + koffs[d0] + 4096); } } while (0)
#define ATT_QKM(N0, N1, KF, QX) do { \
        N0 = __builtin_amdgcn_mfma_f32_32x32x16_bf16(kx0, QX, zero16, 0, 0, 0); N1 = __builtin_amdgcn_mfma_f32_32x32x16_bf16(kx1, QX, zero16, 0, 0, 0); \
        _Pragma("unroll") for (int d0 = 0; d0 < 4; ++d0) { \
            N0 = __builtin_amdgcn_mfma_f32_32x32x16_bf16(KF[2 * d0], qr[d0], N0, 0, 0, 0); N1 = __builtin_amdgcn_mfma_f32_32x32x16_bf16(KF[2 * d0 + 1], qr[d0], N1, 0, 0, 0); } } while (0)
#define ATT_ROWMAX(RM, X0, X1) do { float a_ = max3f(X0[0], X0[1], X1[0]), b_ = max3f(X0[2], X0[3], X1[1]); a_ = max3f(a_, X1[2], X1[3]); \
        _Pragma("unroll") for (int r = 4; r < 16; r += 4) { a_ = max3f(a_, X0[r], X0[r + 1]); b_ = max3f(b_, X0[r + 2], X0[r + 3]); a_ = max3f(a_, X1[r], X1[r + 1]); b_ = max3f(b_, X1[r + 2], X1[r + 3]); } \
        RM = max3f(a_, b_, b_); } while (0)
#define SB_ __builtin_amdgcn_sched_barrier(0)
#define EXPCH(X, base, n) do { _Pragma("unroll") for (int r = (base); r < (base) + (n); ++r) X[r] = __builtin_amdgcn_exp2f(X[r] - sub_); } while (0)
#define VREAD(VF, ks) do { _Pragma("unroll") for (int d0 = 0; d0 < 4; ++d0) VF[d0] = *(const LAS bf16x8*)(vb_ + voffs[ks] + d0 * 4096); } while (0)
#define PVG(ks, VF, d0, SUMST, MAXST) do { o[d0] = __builtin_amdgcn_mfma_f32_32x32x16_bf16(pa_[ks], VF[d0], o[d0], 0, 0, 0); SUMST; MAXST; SB_; } while (0)
#define ATT_STEP(C0, C1, CCST, CDIAG, RMC, N0, N1, NCST, NDIAG, RMN, j, HN) do { \
        if (CDIAG) { const float dts_ = (float)(tpos - 64 * TILE(j) - 8 * hi); \
            _Pragma("unroll") for (int r = 0; r < 16; ++r) { const float c_ = (float)(16 * (r >> 3) + (r & 7)); \
                C0[r] = __builtin_fmaf(-m2, __builtin_fabsf(dts_ - c_), C0[r]); C1[r] = __builtin_fmaf(-m2, __builtin_fabsf(dts_ - (c_ + 32.f)), C1[r]); } \
            float rm2_; ATT_ROWMAX(rm2_, C0, C1); RMC = xor32_max(rm2_); } \
        if (__any(RMC > mref + 8.0f)) { \
            const float mnew_ = __builtin_fmaxf(mref, RMC); const float f_ = __builtin_amdgcn_exp2f(mref - mnew_); \
            l *= f_; mref = mnew_; \
            if (hi == 0) wsf[r32] = f_; \
            asm volatile("s_waitcnt lgkmcnt(0)" ::: "memory"); \
            _Pragma("unroll") for (int r = 0; r < 16; ++r) { const float fr_ = wsf[crow(r, hi)]; \
                _Pragma("unroll") for (int d0 = 0; d0 < 4; ++d0) o[d0][r] *= fr_; } } \
        const bool skip_ = __all(RMC < mref - 150.0f);     \
        const float sub_ = mref - CCST; \
        bf16x8 kf_[8]; bf16x8 qx_ = qr[0]; \
        if (HN) { ATT_SIDE(qx_, NCST, NDIAG, (j) + 1); ATT_KREAD(kf_, (j) + 1); asm volatile("" ::: "memory"); } \
        bf16x8 pa_[4]; u32x4 w_; \
        SB_; \
        if (HN) N0 = __builtin_amdgcn_mfma_f32_32x32x16_bf16(kx0, qx_, zero16, 0, 0, 0); EXPCH(C0, 0, 3); SB_; \
        if (HN) N1 = __builtin_amdgcn_mfma_f32_32x32x16_bf16(kx1, qx_, zero16, 0, 0, 0); EXPCH(C0, 3, 3); SB_; \
        if (HN) N0 = __builtin_amdgcn_mfma_f32_32x32x16_bf16(kf_[0], qr[0], N0, 0, 0, 0); EXPCH(C0, 6, 3); SB_; \
        if (HN) N1 = __builtin_amdgcn_mfma_f32_32x32x16_bf16(kf_[1], qr[0], N1, 0, 0, 0); EXPCH(C0, 9, 3); SB_; \
        if (HN) N0 = __builtin_amdgcn_mfma_f32_32x32x16_bf16(kf_[2], qr[1], N0, 0, 0, 0); EXPCH(C0, 12, 4); SB_; \
        if ((j) + 3 < 32) { DMA_K(TILE((j) + 3), (j) % 3); } SB_; \
        if (HN) N1 = __builtin_amdgcn_mfma_f32_32x32x16_bf16(kf_[3], qr[1], N1, 0, 0, 0); EXPCH(C1, 0, 3); \
          w_.x = pk2(C0[0], C0[1]); w_.y = pk2(C0[2], C0[3]); w_.z = pk2(C0[4], C0[5]); w_.w = pk2(C0[6], C0[7]); pa_[0] = __builtin_bit_cast(bf16x8, w_); SB_; \
        if (HN) N0 = __builtin_amdgcn_mfma_f32_32x32x16_bf16(kf_[4], qr[2], N0, 0, 0, 0); EXPCH(C1, 3, 3); \
          w_.x = pk2(C0[8], C0[9]); w_.y = pk2(C0[10], C0[11]); w_.z = pk2(C0[12], C0[13]); w_.w = pk2(C0[14], C0[15]); pa_[1] = __builtin_bit_cast(bf16x8, w_); SB_; \
        if (HN) N1 = __builtin_amdgcn_mfma_f32_32x32x16_bf16(kf_[5], qr[2], N1, 0, 0, 0); EXPCH(C1, 6, 3); SB_; \
        if (HN) N0 = __builtin_amdgcn_mfma_f32_32x32x16_bf16(kf_[6], qr[3], N0, 0, 0, 0); EXPCH(C1, 9, 3); \
          w_.x = pk2(C1[0], C1[1]); w_.y = pk2(C1[2], C1[3]); w_.z = pk2(C1[4], C1[5]); w_.w = pk2(C1[6], C1[7]); pa_[2] = __builtin_bit_cast(bf16x8, w_); SB_; \
        if (HN) N1 = __builtin_amdgcn_mfma_f32_32x32x16_bf16(kf_[7], qr[3], N1, 0, 0, 0); EXPCH(C1, 12, 4); \
          w_.x = pk2(C1[8], C1[9]); w_.y = pk2(C1[10], C1[11]); w_.z = pk2(C1[12], C1[13]); w_.w = pk2(C1[14], C1[15]); pa_[3] = __builtin_bit_cast(bf16x8, w_); SB_; \
        if ((j) < 29) asm volatile("s_waitcnt vmcnt(4) lgkmcnt(0)\n\ts_barrier" ::: "memory"); \
        else asm volatile("s_waitcnt vmcnt(0) lgkmcnt(0)\n\ts_barrier" ::: "memory"); \
        __builtin_amdgcn_s_setprio(1); \
        if ((j) + 2 < 32) { DMA_V(TILE((j) + 2), ((j) + 2) % 3); } \
        if (!skip_) { const LAS unsigned char* vb_ = lds + ATT_V + ((j) % 3) * VSLOT; \
          bf16x8 vfa_[4], vfb_[4]; float ls_ = 0.f, ma_ = -3.0e38f; \
          VREAD(vfa_, 0); VREAD(vfb_, 1); asm volatile("" ::: "memory"); SB_; \
          PVG(0, vfa_, 0, ls_ += C0[0] + C0[1], (void)0); \
          PVG(0, vfa_, 1, ls_ += C0[2] + C0[3], (void)0); \
          PVG(0, vfa_, 2, ls_ += C0[4] + C0[5], (void)0); \
          PVG(0, vfa_, 3, ls_ += C0[6] + C0[7], (void)0); \
          VREAD(vfa_, 2); asm volatile("" ::: "memory"); SB_; \
          PVG(1, vfb_, 0, ls_ += C0[8] + C0[9], (void)0); \
          PVG(1, vfb_, 1, ls_ += C0[10] + C0[11], (void)0); \
          PVG(1, vfb_, 2, ls_ += C0[12] + C0[13], (void)0); \
          PVG(1, vfb_, 3, ls_ += C0[14] + C0[15], (void)0); \
          VREAD(vfb_, 3); asm volatile("" ::: "memory"); SB_; \
          PVG(2, vfa_, 0, ls_ += C1[0] + C1[1], (void)0); \
          PVG(2, vfa_, 1, ls_ += C1[2] + C1[3], (void)0); \
          PVG(2, vfa_, 2, ls_ += C1[4] + C1[5], (void)0); \
          PVG(2, vfa_, 3, ls_ += C1[6] + C1[7], (void)0); \
          PVG(3, vfb_, 0, ls_ += C1[8] + C1[9], (void)0); \
          PVG(3, vfb_, 1, ls_ += C1[10] + C1[11], (void)0); \
          PVG(3, vfb_, 2, ls_ += C1[12] + C1[13], (void)0); \
          PVG(3, vfb_, 3, ls_ += C1[14] + C1[15], (void)0); \
          l += ls_; } \
        if (HN) { float rmn_; ATT_ROWMAX(rmn_, N0, N1); RMN = xor32_max(rmn_) + NCST; } \
        __builtin_amdgcn_s_setprio(0); \
        if ((j) < 29) asm volatile("s_waitcnt vmcnt(4) lgkmcnt(0)\n\ts_barrier" ::: "memory"); \
        else asm volatile("s_waitcnt vmcnt(0) lgkmcnt(0)\n\ts_barrier" ::: "memory"); \
    } while (0)

    asm volatile("s_waitcnt vmcnt(4)\n\ts_barrier" ::: "memory");
    float rmA = 0.f, rmB = 0.f;
    { bf16x8 kf0_[8]; bf16x8 qx0_; ATT_SIDE(qx0_, cstA, diagA, 0); ATT_KREAD(kf0_, 0); ATT_QKM(A0, A1, kf0_, qx0_);
      float rm_; ATT_ROWMAX(rm_, A0, A1); rmA = xor32_max(rm_) + cstA; }
    asm volatile("s_waitcnt lgkmcnt(0)\n\ts_barrier" ::: "memory");
    if (mp == 1) asm volatile("s_barrier" ::: "memory");
#pragma unroll 1
    for (int jj = 0; jj < 30; jj += 2) {
        ATT_STEP(A0, A1, cstA, diagA, rmA, B0, B1, cstB, diagB, rmB, jj, 1);
        ATT_STEP(B0, B1, cstB, diagB, rmB, A0, A1, cstA, diagA, rmA, jj + 1, 1);
    }
    ATT_STEP(A0, A1, cstA, diagA, rmA, B0, B1, cstB, diagB, rmB, 30, 1);
    ATT_STEP(B0, B1, cstB, diagB, rmB, A0, A1, cstA, diagA, rmA, 31, 0);
    if (mp == 0) asm volatile("s_barrier" ::: "memory");
#undef ATT_STEP
#undef SB_
#undef EXPCH
#undef VREAD
#undef PVG
#undef ATT_QKM
#undef ATT_KREAD
#undef ATT_SIDE
#undef ATT_ROWMAX
#undef DMA_K
#undef DMA_V
#undef TILE
    const int fr_row = 16 * mp + (lane >> 4), fr_col = 4 * (lane & 15);
    u32x2 zA[4], zB[4];
    {
        const bf16_t* zp = szb + (size_t)(b * SEQ + T0 + fr_row) * DM + h * 128 + fr_col;
#pragma unroll
        for (int i = 0; i < 4; ++i) { zA[i] = *(const u32x2*)(zp + (size_t)(4 * i) * DM); zB[i] = *(const u32x2*)(zp + (size_t)(4 * i) * DM + 64); }
    }
    l = xor32_sum(l);
    if (hi == 0) wsf[32 + r32] = l;
    asm volatile("s_waitcnt lgkmcnt(0)" ::: "memory");
    LAS float* xch = (LAS float*)(lds + ATT_X) + wid * 4096;
    const float msc = mp == 0 ? 1.0f : -lam;
#pragma unroll
    for (int r = 0; r < 16; ++r) {
        const float rl = __builtin_amdgcn_rcpf(wsf[32 + crow(r, hi)]) * msc;
#pragma unroll
        for (int d0 = 0; d0 < 4; ++d0) xch[crow(r, hi) * 128 + 32 * d0 + r32] = o[d0][r] * rl;
    }
    asm volatile("s_waitcnt lgkmcnt(0)\n\ts_barrier" ::: "memory");
    {
        const LAS float* xa = (const LAS float*)(lds + ATT_X) + wq * 4096, * xb_ = xa + 4 * 4096;
        bf16_t* op = o_out + (size_t)(b * SEQ + T0 + fr_row) * DM + h * 128 + fr_col;
        const f32x4 gA = *(const f32x4*)(subln_g + fr_col) * (1.0f - LAMBDA_INIT), gB = *(const f32x4*)(subln_g + 64 + fr_col) * (1.0f - LAMBDA_INIT);
#pragma unroll
        for (int i = 0; i < 4; ++i) {
            const int ro = (fr_row + 4 * i) * 128 + fr_col;
            const f32x4 ya = *(const LAS f32x4*)(xa + ro) + *(const LAS f32x4*)(xb_ + ro), yb = *(const LAS f32x4*)(xa + ro + 64) + *(const LAS f32x4*)(xb_ + ro + 64);
            float ss = (ya[0] * ya[0] + ya[1] * ya[1]) + (ya[2] * ya[2] + ya[3] * ya[3]) + (yb[0] * yb[0] + yb[1] * yb[1]) + (yb[2] * yb[2] + yb[3] * yb[3]);
            ss = row16_sum(ss);
            const float rs = __builtin_amdgcn_rsqf(ss * (1.0f / 128.0f) + RMS_EPS);
            const f32x4 za = (f32x4){bf_lo(zA[i].x), bf_hi(zA[i].x), bf_lo(zA[i].y), bf_hi(zA[i].y)}, zb = (f32x4){bf_lo(zB[i].x), bf_hi(zB[i].x), bf_lo(zB[i].y), bf_hi(zB[i].y)};
            const f32x4 va = ya * rs * gA * za, vb = yb * rs * gB * zb;
            u32x2 wa, wb; wa.x = pk2(va[0], va[1]); wa.y = pk2(va[2], va[3]); wb.x = pk2(vb[0], vb[1]); wb.y = pk2(vb[2], vb[3]);
            *(u32x2*)(op + (size_t)(4 * i) * DM) = wa; *(u32x2*)(op + (size_t)(4 * i) * DM + 64) = wb;
        }
    }
}

__global__ void __launch_bounds__(512, 2) fwd_mega(Args a) {
    extern __shared__ __attribute__((aligned(16))) unsigned char lds_raw[];
    LAS unsigned char* lds = (LAS unsigned char*)lds_raw;
    cg::grid_group grid = cg::this_grid();
    const int G = gridDim.x, bx = blockIdx.x;
    const int wave_s = __builtin_amdgcn_readfirstlane((int)(threadIdx.x >> 6));
#define FRESH_TID() const int tid_l = fresh_tid(wave_s); const int tid = tid_l, lane = tid & 63; const int wave = __builtin_amdgcn_readfirstlane(tid >> 6); (void)lane; (void)wave
    const int vcu = (G % 8 == 0) ? (bx % 8) * (G / 8) + bx / 8 : bx;
    unsigned char* ws = a.ws;
    bf16_t* Wt = (bf16_t*)(ws + WS_WIN); bf16_t* Wa_t = (bf16_t*)(ws + WS_WA); bf16_t* Wb_t = (bf16_t*)(ws + WS_WB); bf16_t* Wo_t = (bf16_t*)(ws + WS_WOUT);
    bf16_t* Wg_t = (bf16_t*)(ws + WS_WG); bf16_t* Wp_t = (bf16_t*)(ws + WS_WPLE); bf16_t* pb = (bf16_t*)(ws + WS_PB);
    bf16_t* xb = (bf16_t*)(ws + WS_XB); bf16_t* obuf = xb;
    bf16_t* hcu = (bf16_t*)(ws + WS_HCU);
    bf16_t* gap = (bf16_t*)(ws + WS_GAP); bf16_t* rb = gap;
    bf16_t* qbuf = (bf16_t*)(ws + WS_Q); float* rbuf = (float*)(ws + WS_Q); bf16_t* merged = qbuf;
    bf16_t* kbuf = (bf16_t*)(ws + WS_K);
    bf16_t* vT = (bf16_t*)(ws + WS_VT);
    bf16_t* szb = (bf16_t*)(ws + WS_SZB); bf16_t* ple = szb;
    bf16_t* sga = (bf16_t*)a.out; bf16_t* sgb = sga + (size_t)TOK * DM;

    {
        FRESH_TID();
        const int gthreads = G * 512, gtid = vcu * 512 + tid;
        cvt_rows(a.x, xb, (size_t)TOK * DM / 8, gtid, gthreads);
        cvt_rows(a.p, pb, (size_t)TOK * PLE / 8, gtid, gthreads);
        LAS float* scr = (LAS float*)(lds + wave * 16384);
        const int gw = vcu * 8 + wave, NGW = G * 8;
        constexpr int I_IN = 16 * 320, I_SQ = 16 * 32, I_PLE = 4 * 32, NITEMS = I_IN + 4 * I_SQ + I_PLE;
        for (int it = gw; it < NITEMS; it += NGW) {
            int r = it;
            if (r < I_IN) { const int kb = r / 320, nb = r % 320; transpose_item(a.w_in, 1024, 10240, Wt, 64 * kb, win_colmap(32 * nb), 32 * nb, scr, lane); continue; } r -= I_IN;
            if (r < 4 * I_SQ) { const int w = r / I_SQ, rr = r % I_SQ, kb = rr / 32, nb = rr % 32;
                const float* src = w == 0 ? a.w_proj_a : w == 1 ? a.w_proj_b : w == 2 ? a.w_out : a.w_ple_gate;
                bf16_t* dst = w == 0 ? Wa_t : w == 1 ? Wb_t : w == 2 ? Wo_t : Wg_t;
                transpose_item(src, 1024, 1024, dst, 64 * kb, 32 * nb, 32 * nb, scr, lane); continue; } r -= 4 * I_SQ;
            { const int kb = r / 32, nb = r % 32; transpose_item(a.w_ple, 256, 1024, Wp_t, 64 * kb, 32 * nb, 32 * nb, scr, lane); }
        }
    }
    grid.sync();

#ifndef P1_REP
#define P1_REP 1
#endif
#pragma unroll 1
    for (int rep1 = 0; rep1 < P1_REP; ++rep1) {
#if !defined(ONLY_G) || ONLY_G == 1
    {
        Gemm g{xb, Wt, TOK, NMAIN, DM, nullptr, nullptr}; StaticOrder S; S.init(TOK, NMAIN, G, bx);
        EpiProj E{hcu, gap, qbuf, kbuf, szb, sga, sgb};
        gemm_phase<EpiProj, StaticOrder, true, true>(lds, g, S, E, wave_s);
    }
#endif
#if !defined(ONLY_G) || ONLY_G == 2
    {
        Gemm g{Wt + (size_t)NMAIN * DM, xb, 1024, TOK, DM, nullptr, nullptr}; StaticOrder S; S.init(1024, TOK, G, bx);
        EpiVT E{vT};
        gemm_phase<EpiVT, StaticOrder, true, true>(lds, g, S, E, wave_s);
    }
#endif
    }
    grid.sync();

#define PANEL_SEAM() do { asm volatile("s_waitcnt vmcnt(0)" ::: "memory"); __syncthreads(); __builtin_amdgcn_fence(__ATOMIC_ACQUIRE, "agent"); } while (0)
    float lam;
    { FRESH_TID();
      const float s1 = wave_sum(a.lq1[lane] * a.lk1[lane]), s2 = wave_sum(a.lq2[lane] * a.lk2[lane]);
      lam = __builtin_bit_cast(float, __builtin_amdgcn_readfirstlane(__builtin_bit_cast(int, __expf(s1) - __expf(s2) + LAMBDA_INIT))); }
#pragma unroll 1
    for (int panel = vcu; panel < TOK / BM; panel += G) {
        {
            FRESH_TID();
            const int t0 = panel * BM;
            for (int i = tid; i < (BM / 2) * (DM / 8); i += 512) {
                const int t = t0 + 2 * (i >> 7), c8 = (i & 127) * 8, s = t & (SEQ - 1);
                const size_t off = (size_t)t * DM + c8;
                const u32x4 z4 = {0u, 0u, 0u, 0u};
                const u32x4 r1 = *(const u32x4*)(hcu + off), r2 = *(const u32x4*)(hcu + off + DM);
                const u32x4 r0 = s > 0 ? *(const u32x4*)(hcu + off - DM) : z4, r3 = s + 2 < SEQ ? *(const u32x4*)(hcu + off + 2 * DM) : z4;
                const u32x4 g0r = *(const u32x4*)(gap + off), g1r = *(const u32x4*)(gap + off + DM);
                f32x4 h0a, h0b, h1a, h1b, h2a, h2b, h3a, h3b, ga, gb, gc, gd;
                unpack8(r0, h0a, h0b); unpack8(r1, h1a, h1b); unpack8(r2, h2a, h2b); unpack8(r3, h3a, h3b); unpack8(g0r, ga, gb); unpack8(g1r, gc, gd);
                const f32x4 w0a = *(const f32x4*)(a.conv_w + c8), w0b = *(const f32x4*)(a.conv_w + c8 + 4);
                const f32x4 w1a = *(const f32x4*)(a.conv_w + DM + c8), w1b = *(const f32x4*)(a.conv_w + DM + c8 + 4);
                const f32x4 w2a = *(const f32x4*)(a.conv_w + 2 * DM + c8), w2b = *(const f32x4*)(a.conv_w + 2 * DM + c8 + 4);
                const f32x4 cba = *(const f32x4*)(a.conv_b + c8), cbb = *(const f32x4*)(a.conv_b + c8 + 4);
                *(u32x4*)(gap + off) = pack8(ga * (w0a * h0a + w1a * h1a + w2a * h2a + cba), gb * (w0b * h0b + w1b * h1b + w2b * h2b + cbb));
                *(u32x4*)(gap + off + DM) = pack8(gc * (w0a * h1a + w1a * h2a + w2a * h3a + cba), gd * (w0b * h1b + w1b * h2b + w2b * h3b + cbb));
            }
        }
#pragma unroll 1
        for (int un = 0; un < 16; ++un)
            attn_unit(lds, qbuf, kbuf, vT, szb, obuf, a.subln_g, lam, panel >> 3, un >> 1, 2 * (panel & 7) + (un & 1), wave_s);
        PANEL_SEAM();
        const PanelOrder S4{panel, DM / BM};
        { Gemm g{gap, Wa_t, TOK, DM, DM, obuf, Wb_t}; const PanelOrder2 S2{panel, DM / BM}; EpiMerge E{sga, merged}; gemm_phase<EpiMerge, PanelOrder2, true, true>(lds, g, S2, E, wave_s); }
        PANEL_SEAM();
        { Gemm g{merged, Wo_t, TOK, DM, DM, nullptr, nullptr}; EpiRes E{a.x, rbuf, rb}; gemm_phase<EpiRes, PanelOrder, true, true>(lds, g, S4, E, wave_s); }
        { Gemm g{pb, Wp_t, TOK, DM, PLE, nullptr, nullptr}; EpiStore E{ple}; gemm_phase<EpiStore, PanelOrder, true, true>(lds, g, S4, E, wave_s); }
        PANEL_SEAM();
        { Gemm g{rb, Wg_t, TOK, DM, DM, nullptr, nullptr}; EpiPle E{ple}; gemm_phase<EpiPle, PanelOrder, true, true>(lds, g, S4, E, wave_s); }
        PANEL_SEAM();
        {
            FRESH_TID();
            f32x4 gg[4], bb[4];
#pragma unroll
            for (int j = 0; j < 4; ++j) { gg[j] = *((const f32x4*)a.ln_g + lane + 64 * j); bb[j] = *((const f32x4*)a.ln_b + lane + 64 * j); }
#pragma unroll 1
            for (int rr = wave; rr < BM; rr += 8) {
                const int m = panel * BM + rr;
                const u32x2* xr = (const u32x2*)(rb + (size_t)m * DM) + lane; const u32x2* dr = (const u32x2*)(ple + (size_t)m * DM) + lane;
                f32x4 v[4]; float s_ = 0.f;
#pragma unroll
                for (int j = 0; j < 4; ++j) { const u32x2 a_ = xr[64 * j], d_ = dr[64 * j];
                    v[j] = (f32x4){bf_lo(a_.x) + bf_lo(d_.x), bf_hi(a_.x) + bf_hi(d_.x), bf_lo(a_.y) + bf_lo(d_.y), bf_hi(a_.y) + bf_hi(d_.y)}; s_ += (v[j].x + v[j].y) + (v[j].z + v[j].w); }
                const float mean = wave_sum(s_) * (1.f / DM); float s2 = 0.f;
#pragma unroll
                for (int j = 0; j < 4; ++j) { v[j] = v[j] - mean; s2 += (v[j].x * v[j].x + v[j].y * v[j].y) + (v[j].z * v[j].z + v[j].w * v[j].w); }
                const float rstd = __builtin_amdgcn_rsqf(wave_sum(s2) * (1.f / DM) + LN_EPS);
                f32x4* orow = (f32x4*)(a.out + (size_t)m * DM) + lane;
#pragma unroll
                for (int j = 0; j < 4; ++j) orow[64 * j] = v[j] * rstd * gg[j] + bb[j];
            }
        }
        PANEL_SEAM();
    }
#undef PANEL_SEAM
}

extern "C" void kernel_launch(void* const* d_in, const int* in_sizes, int n_in, void* d_out, int out_size, void* d_ws, size_t ws_size, hipStream_t stream) {
    static int grid = 0;
    if (grid == 0) {
        if (n_in != 17 || in_sizes[0] != TOK * DM || out_size != TOK * DM || ws_size < WS_END) { fprintf(stderr, "kernel_launch: unexpected shapes (n_in %d, in0 %d, out %d, ws %zu)\n", n_in, n_in > 0 ? in_sizes[0] : -1, out_size, ws_size); grid = -1; return; }
        int dev = 0, cus = 0, per_cu = 0;
        (void)hipGetDevice(&dev); (void)hipDeviceGetAttribute(&cus, hipDeviceAttributeMultiprocessorCount, dev);
        if (hipFuncSetAttribute((const void*)fwd_mega, hipFuncAttributeMaxDynamicSharedMemorySize, LDS_BYTES) != hipSuccess) { fprintf(stderr, "kernel_launch: hipFuncSetAttribute failed\n"); grid = -1; return; }
        if (hipOccupancyMaxActiveBlocksPerMultiprocessor(&per_cu, (const void*)fwd_mega, 512, LDS_BYTES) != hipSuccess || per_cu < 1) { fprintf(stderr, "kernel_launch: occupancy query says %d\n", per_cu); per_cu = 1; }
        (void)hipGetLastError();
        grid = cus * per_cu;
    }
    if (grid < 0) return;
    Args a{};
    a.x = (const float*)d_in[0]; a.p = (const float*)d_in[1]; a.w_in = (const float*)d_in[2]; a.conv_w = (const float*)d_in[3]; a.conv_b = (const float*)d_in[4];
    a.w_proj_a = (const float*)d_in[5]; a.lq1 = (const float*)d_in[6]; a.lk1 = (const float*)d_in[7]; a.lq2 = (const float*)d_in[8]; a.lk2 = (const float*)d_in[9];
    a.subln_g = (const float*)d_in[10]; a.w_proj_b = (const float*)d_in[11]; a.w_out = (const float*)d_in[12]; a.w_ple = (const float*)d_in[13]; a.w_ple_gate = (const float*)d_in[14];
    a.ln_g = (const float*)d_in[15]; a.ln_b = (const float*)d_in[16];
    a.out = (float*)d_out; a.ws = (unsigned char*)d_ws;
    void* args[] = {&a};
    hipError_t e = hipLaunchCooperativeKernel((const void*)fwd_mega, dim3(grid), dim3(512), args, LDS_BYTES, stream);
    if (e != hipSuccess) fprintf(stderr, "kernel_launch: cooperative launch failed: %s (grid %d)\n", hipGetErrorString(e), grid);
}
```

```cpp
#include <hip/hip_runtime.h>
#include <cstdio>
#include <cstdint>
__device__ __forceinline__ int fresh_tid(int wave_s) { int l; asm volatile("v_mbcnt_lo_u32_b32 %0, -1, 0\n\tv_mbcnt_hi_u32_b32 %0, -1, %0" : "=v"(l)); return wave_s * 64 + l; }
namespace pg8 {
#define PG8_LAS __attribute__((address_space(3)))
typedef unsigned short bf16_t;
typedef short bf16x8 __attribute__((ext_vector_type(8)));
typedef float f32x4 __attribute__((ext_vector_type(4)));
typedef unsigned u32x4 __attribute__((ext_vector_type(4)));
constexpr int BM = 256, BK = 64, HALF = 128, HTB = HALF * BK * 2  , STAGE_BYTES = 8 * HTB, NXCD = 8, WGM = 8;

__host__ __device__ __forceinline__ int lds_byte(int r, int c) { const int st = (r >> 4) * 2 + (c >> 5), rr = r & 15, cc = c & 31, ob = rr * 64 + cc * 2; return st * 1024 + (ob ^ (((ob >> 9) & 1) << 5)); }
__host__ __device__ __forceinline__ void stage_rc(int b, int& R, int& C) { const int st = b / 1024, sb = b % 1024, swz = sb ^ (((sb >> 9) & 1) << 5); R = (st >> 1) * 16 + swz / 64; C = (st & 1) * 32 + (swz % 64) / 2; }
__host__ __device__ __forceinline__ int perm32(int rho) { const int n = rho >> 4, i = rho & 15; return 8 * (i >> 2) + 4 * n + (i & 3); }

struct Unit { int pm, pn, sel; };
struct Gemm { const bf16_t* A; const bf16_t* Bt; int M, N, K; const bf16_t* A2; const bf16_t* Bt2; };

struct StaticOrder {
    int nM, nN, nwg, G, c;
    __host__ __device__ void init(int M, int N, int G_, int c_) { nM = M / BM; nN = N / BM; nwg = nM * nN; G = G_; c = c_; }
    __host__ __device__ bool next(int i, Unit& u) const {
        const long L = (long)i * G + c; if (L >= nwg) return false;
        int wgid = (int)L; { const int q = nwg / NXCD, r = nwg % NXCD, xcd = wgid % NXCD, off = wgid / NXCD; wgid = (xcd < r ? xcd * (q + 1) : r * (q + 1) + (xcd - r) * q) + off; }
        const int nig = WGM * nN, gid = wgid / nig, fm = gid * WGM, gsz = (nM - fm) < WGM ? (nM - fm) : WGM;
        u.pm = fm + ((wgid % nig) % gsz); u.pn = (wgid % nig) / gsz; return true;
    }
    __device__ __forceinline__ void a_ready(const Unit&) const {}
    __device__ __forceinline__ void done(const Unit&) const {}
};

__device__ __forceinline__ unsigned cvt_pk_bf16(float lo, float hi) { unsigned r; asm volatile("v_cvt_pk_bf16_f32 %0, %1, %2" : "=v"(r) : "v"(lo), "v"(hi)); return r; }
template <class Epi, class Sched, bool ALIGN_EPI = false, bool SP2 = false>
__device__ __forceinline__ void gemm_phase(PG8_LAS unsigned char* lds, const Gemm g, const Sched& S, const Epi& E, int wave_s) {
    int tid_ = fresh_tid(wave_s);
    const int tid = tid_, wid = __builtin_amdgcn_readfirstlane(tid >> 6), lane = tid & 63, wr = wid >> 2, wc = wid & 3, fr = lane & 15, fq = lane >> 4;
    const int K = g.K, nt = K / BK;
    unsigned voffA[2], voffB[2];
#pragma unroll
    for (int i = 0; i < 2; ++i) { int R, C; stage_rc(tid * 16 + i * 8192, R, C); const int Rb = Epi::PERM ? ((R & ~31) + perm32(R & 31)) : R;
        voffA[i] = (unsigned)(R * K + C) * 2u; voffB[i] = (unsigned)(Rb * K + C) * 2u; }
    const size_t kstep = (size_t)(BK * 2);
    const size_t hstep = (size_t)HALF * K * 2;
    const size_t tstep = 2 * hstep;
    const unsigned ldsw = (unsigned)wid * 1024u;
    const int aoff = lds_byte(wr * 64 + fr, fq * 8), boff = lds_byte(wc * 32 + fr, fq * 8);
#define PG8_SA(b, h) (((b) * 2 + (h)) * HTB)
#define PG8_SB(b, h) ((4 + (b) * 2 + (h)) * HTB)
#define PG8_STAGE(bufoff, gbase, voff) do { _Pragma("unroll") for (int _i = 0; _i < 2; ++_i) \
        __builtin_amdgcn_global_load_lds((const unsigned*)((const char*)(gbase) + (voff)[_i]), (PG8_LAS unsigned*)(lds + (bufoff) + ldsw + _i * 8192), 16, 0, 0); } while (0)
#define PG8_LDA(dst, b, h) do { _Pragma("unroll") for (int m = 0; m < 4; ++m) _Pragma("unroll") for (int k = 0; k < 2; ++k) dst[m][k] = *(const PG8_LAS bf16x8*)(lds + PG8_SA(b, h) + aoff + m * 2048 + k * 1024); } while (0)
#define PG8_LDB(dst, b, h) do { _Pragma("unroll") for (int n = 0; n < 2; ++n) _Pragma("unroll") for (int k = 0; k < 2; ++k) dst[n][k] = *(const PG8_LAS bf16x8*)(lds + PG8_SB(b, h) + boff + n * 2048 + k * 1024); } while (0)
#define PG8_MMA(ai, bj, At, Bt) do { __builtin_amdgcn_s_setprio(1); _Pragma("unroll") for (int m = 0; m < 4; ++m) _Pragma("unroll") for (int n = 0; n < 2; ++n) _Pragma("unroll") for (int k = 0; k < 2; ++k) \
        acc[ai][bj][m][n] = __builtin_amdgcn_mfma_f32_16x16x32_bf16(Bt[n][k], At[m][k], acc[ai][bj][m][n], 0, 0, 0); __builtin_amdgcn_s_setprio(0); } while (0)
#define PG8_WAIT_V(n) asm volatile("s_waitcnt vmcnt(" #n ")" ::: "memory")
#define PG8_WAIT_L(n) asm volatile("s_waitcnt lgkmcnt(" #n ")" ::: "memory")
#define PG8_BAR __builtin_amdgcn_s_barrier()
#define PG8_SCHED __builtin_amdgcn_sched_barrier(0)
    Unit cur, nxt; int ui = 0;
    if (!S.next(0, cur)) return;
    f32x4 acc[2][2][4][2];
#pragma unroll
    for (int a = 0; a < 2; ++a)
#pragma unroll
        for (int b = 0; b < 2; ++b)
#pragma unroll
            for (int m = 0; m < 4; ++m)
#pragma unroll
                for (int n = 0; n < 2; ++n) acc[a][b][m][n] = (f32x4){0.f, 0.f, 0.f, 0.f};
    bf16x8 At[4][2], B0[2][2], B1[2][2];
    const char* cA; const char* cB;
    if constexpr (Epi::FUSED2) { cA = (const char*)(cur.sel ? g.A2 : g.A) + (size_t)cur.pm * tstep; cB = (const char*)(cur.sel ? g.Bt2 : g.Bt) + (size_t)cur.pn * tstep; }
    else { cA = (const char*)g.A + (size_t)cur.pm * tstep; cB = (const char*)g.Bt + (size_t)cur.pn * tstep; }
    S.a_ready(cur);
    if constexpr (SP2) {
        PG8_STAGE(PG8_SB(0, 0), cB, voffB); PG8_STAGE(PG8_SB(0, 1), cB + hstep, voffB); PG8_STAGE(PG8_SA(0, 0), cA, voffA); PG8_STAGE(PG8_SA(0, 1), cA + hstep, voffA);
        if (wr == 1) PG8_BAR;
        PG8_WAIT_V(2); PG8_BAR;
        PG8_STAGE(PG8_SB(1, 0), cB + kstep, voffB); PG8_STAGE(PG8_SA(1, 0), cA + kstep, voffA); PG8_STAGE(PG8_SB(1, 1), cB + hstep + kstep, voffB);
        PG8_WAIT_V(6); PG8_BAR;
    } else {
        PG8_STAGE(PG8_SB(0, 0), cB, voffB); PG8_STAGE(PG8_SA(0, 0), cA, voffA); PG8_STAGE(PG8_SB(0, 1), cB + hstep, voffB); PG8_STAGE(PG8_SA(0, 1), cA + hstep, voffA);
        if (wr == 1) PG8_BAR;
        PG8_WAIT_V(4); PG8_BAR;
        PG8_STAGE(PG8_SB(1, 0), cB + kstep, voffB); PG8_STAGE(PG8_SA(1, 0), cA + kstep, voffA); PG8_STAGE(PG8_SB(1, 1), cB + hstep + kstep, voffB);
        PG8_WAIT_V(6); PG8_BAR;
    }
    for (;;) {
        const bool has_next = S.next(ui + 1, nxt);
        const char* nA; const char* nB;
        if constexpr (Epi::FUSED2) { nA = has_next ? (const char*)(nxt.sel ? g.A2 : g.A) + (size_t)nxt.pm * tstep : cA; nB = has_next ? (const char*)(nxt.sel ? g.Bt2 : g.Bt) + (size_t)nxt.pn * tstep : cB; }
        else { nA = has_next ? (const char*)g.A + (size_t)nxt.pm * tstep : cA; nB = has_next ? (const char*)g.Bt + (size_t)nxt.pn * tstep : cB; }
#pragma unroll 1
        for (int t = 0; t < nt; t += 2) {
            const bool last = (t == nt - 2);
            const char* a1 = cA + (size_t)(t + 1) * kstep;
            const char* a2 = last ? nA : cA + (size_t)(t + 2) * kstep; const char* b2 = last ? nB : cB + (size_t)(t + 2) * kstep;
            const char* a3 = a2 + kstep; const char* b3 = b2 + kstep;
            if (last && has_next) S.a_ready(nxt);
            if constexpr (SP2) {
            PG8_LDB(B0, 0, 0); PG8_LDB(B1, 0, 1); PG8_SCHED; PG8_LDA(At, 0, 0); PG8_STAGE(PG8_SA(1, 1), a1 + hstep, voffA);
            PG8_WAIT_V(8); PG8_WAIT_L(0); PG8_BAR; PG8_MMA(0, 0, At, B0); PG8_MMA(0, 1, At, B1); PG8_BAR; PG8_SCHED;
            PG8_LDA(At, 0, 1); PG8_STAGE(PG8_SB(0, 0), b2, voffB); PG8_STAGE(PG8_SB(0, 1), b2 + hstep, voffB); PG8_STAGE(PG8_SA(0, 0), a2, voffA);
            PG8_WAIT_V(8); PG8_WAIT_L(0); PG8_BAR; PG8_MMA(1, 0, At, B0); PG8_MMA(1, 1, At, B1); PG8_BAR; PG8_SCHED;
            PG8_LDB(B0, 1, 0); PG8_LDB(B1, 1, 1); PG8_SCHED; PG8_LDA(At, 1, 0); PG8_STAGE(PG8_SA(0, 1), a2 + hstep, voffA);
            PG8_WAIT_V(8); PG8_WAIT_L(0); PG8_BAR; PG8_MMA(0, 0, At, B0); PG8_MMA(0, 1, At, B1); PG8_BAR; PG8_SCHED;
            PG8_LDA(At, 1, 1); PG8_STAGE(PG8_SB(1, 0), b3, voffB); PG8_STAGE(PG8_SB(1, 1), b3 + hstep, voffB); PG8_STAGE(PG8_SA(1, 0), a3, voffA);
            PG8_WAIT_V(8); PG8_WAIT_L(0); PG8_BAR; PG8_MMA(1, 0, At, B0); PG8_MMA(1, 1, At, B1); PG8_BAR; PG8_SCHED;
            } else {
            PG8_LDB(B0, 0, 0); PG8_SCHED; PG8_LDA(At, 0, 0); PG8_STAGE(PG8_SA(1, 1), a1 + hstep, voffA);
            PG8_WAIT_L(8); PG8_BAR; PG8_WAIT_L(0); PG8_MMA(0, 0, At, B0); PG8_BAR; PG8_SCHED;
            PG8_LDB(B1, 0, 1); PG8_STAGE(PG8_SB(0, 0), b2, voffB);
            PG8_BAR; PG8_WAIT_L(0); PG8_MMA(0, 1, At, B1); PG8_BAR;
            PG8_LDA(At, 0, 1); PG8_STAGE(PG8_SA(0, 0), a2, voffA);
            PG8_BAR; PG8_WAIT_L(0); PG8_MMA(1, 0, At, B0); PG8_BAR; PG8_SCHED;
            PG8_STAGE(PG8_SB(0, 1), b2 + hstep, voffB);
            PG8_WAIT_V(6); PG8_BAR; PG8_MMA(1, 1, At, B1); PG8_BAR;
            PG8_LDB(B0, 1, 0); PG8_SCHED; PG8_LDA(At, 1, 0); PG8_STAGE(PG8_SA(0, 1), a2 + hstep, voffA);
            PG8_WAIT_L(8); PG8_BAR; PG8_WAIT_L(0); PG8_MMA(0, 0, At, B0); PG8_BAR; PG8_SCHED;
            PG8_LDB(B1, 1, 1); PG8_STAGE(PG8_SB(1, 0), b3, voffB);
            PG8_BAR; PG8_WAIT_L(0); PG8_MMA(0, 1, At, B1); PG8_BAR;
            PG8_LDA(At, 1, 1); PG8_STAGE(PG8_SA(1, 0), a3, voffA);
            PG8_BAR; PG8_WAIT_L(0); PG8_MMA(1, 0, At, B0); PG8_BAR; PG8_SCHED;
            PG8_STAGE(PG8_SB(1, 1), b3 + hstep, voffB);
            PG8_WAIT_V(6); PG8_BAR; PG8_MMA(1, 1, At, B1); PG8_BAR;
            }
        }
        if constexpr (ALIGN_EPI) { if (wr == 0) PG8_BAR; }
        if constexpr (!Epi::AFTER_DRAIN) { E(acc, cur, wr, wc, fr, fq); S.done(cur); }
        if (!has_next) break;
        bool keep_acc = false; if constexpr (Epi::FUSED2) keep_acc = (nxt.sel != 0);
        if (!keep_acc) {
#pragma unroll
        for (int a = 0; a < 2; ++a)
#pragma unroll
            for (int b = 0; b < 2; ++b)
#pragma unroll
                for (int m = 0; m < 4; ++m)
#pragma unroll
                    for (int n = 0; n < 2; ++n) acc[a][b][m][n] = (f32x4){0.f, 0.f, 0.f, 0.f};
        }
        cur = nxt; cA = nA; cB = nB; ++ui;
        if constexpr (ALIGN_EPI) { if (wr == 1) PG8_BAR; }
    }
    PG8_WAIT_V(0);
    if constexpr (!ALIGN_EPI) { if (wr == 0) PG8_BAR; }
    PG8_BAR;
    if constexpr (Epi::AFTER_DRAIN) { E.fused(acc, cur, wr, wc, fr, fq, lds, wid, lane); S.done(cur); }
#undef PG8_SA
#undef PG8_SB
#undef PG8_STAGE
#undef PG8_LDA
#undef PG8_LDB
#undef PG8_MMA
#undef PG8_WAIT_V
#undef PG8_WAIT_L
#undef PG8_BAR
#undef PG8_SCHED
}
}

#include <hip/hip_cooperative_groups.h>
namespace cg = cooperative_groups;
using namespace pg8;
#define LAS __attribute__((address_space(3)))
typedef float f32x16 __attribute__((ext_vector_type(16)));
typedef unsigned u32x2 __attribute__((ext_vector_type(2)));

constexpr int TOK = 65536, DM = 1024, SEQ = 2048, NB = 32, NH = 8, PLE = 256;
constexpr int NMAIN = 9216;
constexpr float LOG2E = 1.4426950408889634f;
constexpr float QSCALE = 0.125f * LOG2E;
constexpr float ALPHA = 1.189207115002721f;
constexpr float LAMBDA_INIT = 0.2f;
constexpr float LN_EPS = 1e-5f, RMS_EPS = 1e-5f;

constexpr size_t MiB = 1u << 20, SLOT = 128 * MiB;
constexpr size_t WS_WIN = 0, WS_WA = 20 * MiB, WS_WB = 22 * MiB, WS_WOUT = 24 * MiB, WS_WG = 26 * MiB, WS_WPLE = 28 * MiB, WS_PB = 32 * MiB;
constexpr size_t WS_XB = 1 * SLOT;
constexpr size_t WS_HCU = 2 * SLOT;
constexpr size_t WS_GAP = 3 * SLOT;
constexpr size_t WS_Q = 4 * SLOT;
constexpr size_t WS_K = 5 * SLOT;
constexpr size_t WS_VT = 6 * SLOT;
constexpr size_t WS_SZB = 7 * SLOT;
constexpr size_t WS_END = 8 * SLOT;

constexpr int LDS_BYTES = 147456;

struct Args {
    const float* x; const float* p; const float* w_in; const float* conv_w; const float* conv_b; const float* w_proj_a;
    const float* lq1; const float* lk1; const float* lq2; const float* lk2; const float* subln_g; const float* w_proj_b;
    const float* w_out; const float* w_ple; const float* w_ple_gate; const float* ln_g; const float* ln_b;
    float* out; unsigned char* ws;
};

__device__ __forceinline__ unsigned f2bf(float f) { unsigned u = __builtin_bit_cast(unsigned, f); return (u + 0x7fffu + ((u >> 16) & 1u)) >> 16; }
__device__ __forceinline__ unsigned pk2(float lo, float hi) { return cvt_pk_bf16(lo, hi); }
__device__ __forceinline__ float bf_lo(unsigned u) { return __builtin_bit_cast(float, u << 16); }
__device__ __forceinline__ float bf_hi(unsigned u) { return __builtin_bit_cast(float, u & 0xffff0000u); }
__device__ __forceinline__ float sigmoidf_(float v) { return __builtin_amdgcn_rcpf(1.0f + __builtin_amdgcn_exp2f(-v * LOG2E)); }
__device__ __forceinline__ f32x4 sig4(f32x4 v) { return (f32x4){sigmoidf_(v[0]), sigmoidf_(v[1]), sigmoidf_(v[2]), sigmoidf_(v[3])}; }
__device__ __forceinline__ u32x4 pack8(f32x4 a, f32x4 b) { u32x4 w; w.x = pk2(a[0], a[1]); w.y = pk2(a[2], a[3]); w.z = pk2(b[0], b[1]); w.w = pk2(b[2], b[3]); return w; }
__device__ __forceinline__ void unpack8(u32x4 w, f32x4& a, f32x4& b) { a = (f32x4){bf_lo(w.x), bf_hi(w.x), bf_lo(w.y), bf_hi(w.y)}; b = (f32x4){bf_lo(w.z), bf_hi(w.z), bf_lo(w.w), bf_hi(w.w)}; }

struct PanelOrder {
    int panel, nN;
    __host__ __device__ bool next(int i, Unit& u) const { if (i >= nN) return false; u.pm = panel; u.pn = i; u.sel = 0; return true; }
    __device__ __forceinline__ void a_ready(const Unit&) const {}
    __device__ __forceinline__ void done(const Unit&) const {}
};
struct EpiProj {
    static constexpr bool PERM = true, AFTER_DRAIN = false, FUSED2 = false;
    bf16_t *hcu, *gap, *q, *k, *szb, *sga, *sgb;
    __device__ __forceinline__ void operator()(const f32x4 (&acc)[2][2][4][2], const Unit& u, int wr, int wc, int fr, int fq) const {
        const int row0 = u.pm * BM + wr * 64 + fr;
        if (u.pn < 16) {
            bf16_t* base = (wc < 2) ? hcu : gap;
            const int col = u.pn * 64 + (wc & 1) * 32 + 8 * fq;
#pragma unroll
            for (int ai = 0; ai < 2; ++ai)
#pragma unroll
                for (int m = 0; m < 4; ++m) {
                    f32x4 a0 = acc[ai][0][m][0], a1 = acc[ai][0][m][1], b0 = acc[ai][1][m][0], b1 = acc[ai][1][m][1];
                    if (wc >= 2) { b0 = b0 * sig4(b0); b1 = b1 * sig4(b1); }
                    *(u32x4*)(base + (size_t)(row0 + ai * HALF + m * 16) * DM + col) = pack8(a0 * b0, a1 * b1);
                }
        } else {
            const int t = (u.pn - 16) >> 2;
            bf16_t* base = sga;
            if (t < 3) base = q + (size_t)(t == 2 ? 3 : t) * (SLOT / 2);
            const int col = ((u.pn - 16) & 3) * 256 + wc * 32 + 8 * fq;
#pragma unroll
            for (int ai = 0; ai < 2; ++ai)
#pragma unroll
                for (int m = 0; m < 4; ++m)
#pragma unroll
                    for (int bj = 0; bj < 2; ++bj) {
                        f32x4 v0 = acc[ai][bj][m][0], v1 = acc[ai][bj][m][1];
                        if (t == 0) { v0 = v0 * QSCALE; v1 = v1 * QSCALE; }
                        else if (t == 2) { v0 = v0 * sig4(v0); v1 = v1 * sig4(v1); }
                        else if (t >= 3) { v0 = sig4(v0); v1 = sig4(v1); }
                        const unsigned row = (unsigned)(row0 + ai * HALF + m * 16), cc = (unsigned)(col + bj * HALF);
                        unsigned off = row * DM + cc;
                        if (t >= 3) off = (row >> 8) * 524288u + (unsigned)(t - 3) * 262144u + (row & 255u) * DM + cc;
                        if (t == 1) off = (((((row >> 11) * 8u + (cc >> 7)) * 2u + ((cc >> 6) & 1u)) * 32u + ((row & 2047u) >> 6)) * 64u + (row & 63u)) * 64u + (cc & 63u);
                        *(u32x4*)(base + off) = pack8(v0, v1);
                    }
        }
    }
};
struct EpiVT {
    static constexpr bool PERM = true, AFTER_DRAIN = false, FUSED2 = false;
    bf16_t* vT;
    __device__ __forceinline__ void operator()(const f32x4 (&acc)[2][2][4][2], const Unit& u, int wr, int wc, int fr, int fq) const {
        const int row0 = u.pm * BM + wr * 64 + fr;
        const int col0 = u.pn * BM + wc * 32 + 8 * fq;
        const int b = col0 >> 11;
#pragma unroll
        for (int ai = 0; ai < 2; ++ai)
#pragma unroll
            for (int m = 0; m < 4; ++m)
#pragma unroll
                for (int bj = 0; bj < 2; ++bj) {
                    const int row = row0 + ai * HALF + m * 16, s = (col0 & 2047) + bj * HALF;
                    *(u32x4*)(vT + ((size_t)(((b * 8 + (row >> 7)) * 32 + (s >> 6)) * 128 + (row & 127))) * 64 + (s & 63)) = pack8(acc[ai][bj][m][0], acc[ai][bj][m][1]);
                }
    }
};
struct EpiStore {
    static constexpr bool PERM = true, AFTER_DRAIN = false, FUSED2 = false;
    bf16_t* O; static constexpr int ldc = DM;
    __device__ __forceinline__ void operator()(const f32x4 (&acc)[2][2][4][2], const Unit& u, int wr, int wc, int fr, int fq) const {
        const int row0 = u.pm * BM + wr * 64 + fr, col0 = u.pn * BM + wc * 32 + 8 * fq;
#pragma unroll
        for (int ai = 0; ai < 2; ++ai)
#pragma unroll
            for (int m = 0; m < 4; ++m)
#pragma unroll
                for (int bj = 0; bj < 2; ++bj)
                    *(u32x4*)(O + (size_t)(row0 + ai * HALF + m * 16) * ldc + col0 + bj * HALF) = pack8(acc[ai][bj][m][0], acc[ai][bj][m][1]);
    }
};
template <int MODE> struct EpiGate {
    static constexpr bool PERM = true, AFTER_DRAIN = false, FUSED2 = false;
    const bf16_t* gate; bf16_t* O;
    __device__ __forceinline__ void operator()(const f32x4 (&acc)[2][2][4][2], const Unit& u, int wr, int wc, int fr, int fq) const {
        const int row0 = u.pm * BM + wr * 64 + fr, col0 = u.pn * BM + wc * 32 + 8 * fq;
        const unsigned gbase = (unsigned)u.pm * 524288u + (unsigned)MODE * 262144u + (unsigned)(wr * 64 + fr) * DM + (unsigned)col0;
        const unsigned obase = (unsigned)row0 * DM + (unsigned)col0;
        u32x4 gv[2][2][2], tv[2][2][2];
#define EG_LOAD(q) do { _Pragma("unroll") for (int ml = 0; ml < 2; ++ml) _Pragma("unroll") for (int bj = 0; bj < 2; ++bj) { const int ai = (q) >> 1, m = 2 * ((q) & 1) + ml; \
            gv[(q) & 1][ml][bj] = *(const u32x4*)(gate + gbase + (unsigned)(ai * HALF + m * 16) * DM + bj * HALF); \
            if (MODE == 1) tv[(q) & 1][ml][bj] = *(const u32x4*)(O + (obase + (unsigned)((ai * HALF + m * 16) * DM + bj * HALF))); } } while (0)
#define EG_PROC(q) do { _Pragma("unroll") for (int ml = 0; ml < 2; ++ml) _Pragma("unroll") for (int bj = 0; bj < 2; ++bj) { const int ai = (q) >> 1, m = 2 * ((q) & 1) + ml; \
            f32x4 g0, g1; unpack8(gv[(q) & 1][ml][bj], g0, g1); \
            f32x4 v0 = g0 * acc[ai][bj][m][0], v1 = g1 * acc[ai][bj][m][1]; \
            if (MODE == 1) { f32x4 t0, t1; unpack8(tv[(q) & 1][ml][bj], t0, t1); v0 = v0 + t0; v1 = v1 + t1; } \
            *(u32x4*)(O + (obase + (unsigned)((ai * HALF + m * 16) * DM + bj * HALF))) = pack8(v0, v1); } } while (0)
        EG_LOAD(0); EG_LOAD(1); EG_PROC(0); EG_LOAD(2); EG_PROC(1); EG_LOAD(3); EG_PROC(2); EG_PROC(3);
#undef EG_LOAD
#undef EG_PROC
    }
};
struct EpiMerge {
    static constexpr bool PERM = true, AFTER_DRAIN = false, FUSED2 = true;
    const bf16_t* gate; bf16_t* O;
    __device__ __forceinline__ void operator()(f32x4 (&acc)[2][2][4][2], const Unit& u, int wr, int wc, int fr, int fq) const {
        const int row0 = u.pm * BM + wr * 64 + fr, col0 = u.pn * BM + wc * 32 + 8 * fq;
        const unsigned gbase = (unsigned)u.pm * 524288u + (unsigned)(wr * 64 + fr) * DM + (unsigned)col0;
        const unsigned obase = (unsigned)row0 * DM + (unsigned)col0;
        u32x4 ga_[2][2][2], gb_[2][2][2];
#define EM_LOAD(q) do { _Pragma("unroll") for (int ml = 0; ml < 2; ++ml) _Pragma("unroll") for (int bj = 0; bj < 2; ++bj) { const int ai = (q) >> 1, m = 2 * ((q) & 1) + ml; \
            const unsigned go_ = gbase + (unsigned)((ai * HALF + m * 16) * DM + bj * HALF); \
            gb_[(q) & 1][ml][bj] = *(const u32x4*)(gate + go_ + 262144u); if (!u.sel) ga_[(q) & 1][ml][bj] = *(const u32x4*)(gate + go_); } } while (0)
#define EM_PROC(q) do { _Pragma("unroll") for (int ml = 0; ml < 2; ++ml) _Pragma("unroll") for (int bj = 0; bj < 2; ++bj) { const int ai = (q) >> 1, m = 2 * ((q) & 1) + ml; \
            f32x4 b0, b1; unpack8(gb_[(q) & 1][ml][bj], b0, b1); \
            if (!u.sel) { f32x4 a0, a1; unpack8(ga_[(q) & 1][ml][bj], a0, a1); \
                _Pragma("unroll") for (int i = 0; i < 4; ++i) { acc[ai][bj][m][0][i] *= a0[i] * __builtin_amdgcn_rcpf(__builtin_fmaxf(b0[i], 1e-30f)); acc[ai][bj][m][1][i] *= a1[i] * __builtin_amdgcn_rcpf(__builtin_fmaxf(b1[i], 1e-30f)); } } \
            else { *(u32x4*)(O + (obase + (unsigned)((ai * HALF + m * 16) * DM + bj * HALF))) = pack8(acc[ai][bj][m][0] * b0, acc[ai][bj][m][1] * b1); } } } while (0)
        EM_LOAD(0); EM_LOAD(1); EM_PROC(0); EM_LOAD(2); EM_PROC(1); EM_LOAD(3); EM_PROC(2); EM_PROC(3);
#undef EM_LOAD
#undef EM_PROC
    }
};
struct PanelOrder2 {
    int panel, nN;
    __host__ __device__ bool next(int i, Unit& u) const { if (i >= 2 * nN) return false; u.pm = panel; u.pn = i >> 1; u.sel = i & 1; return true; }
    __device__ __forceinline__ void a_ready(const Unit&) const {}
    __device__ __forceinline__ void done(const Unit&) const {}
};
struct EpiRes {
    static constexpr bool PERM = true, AFTER_DRAIN = false, FUSED2 = false;
    const float* x; float* r; bf16_t* rb;
    __device__ __forceinline__ void operator()(const f32x4 (&acc)[2][2][4][2], const Unit& u, int wr, int wc, int fr, int fq) const {
        const int row0 = u.pm * BM + wr * 64 + fr, col0 = u.pn * BM + wc * 32 + 8 * fq;
        const unsigned obase = (unsigned)row0 * DM + (unsigned)col0;
        f32x4 xs[2][2][2][2];
#define ER_LOAD(q) do { _Pragma("unroll") for (int ml = 0; ml < 2; ++ml) _Pragma("unroll") for (int bj = 0; bj < 2; ++bj) { const int ai = (q) >> 1, m = 2 * ((q) & 1) + ml; \
            const unsigned off = obase + (unsigned)((ai * HALF + m * 16) * DM + bj * HALF); \
            xs[(q) & 1][ml][bj][0] = *(const f32x4*)(x + off); xs[(q) & 1][ml][bj][1] = *(const f32x4*)(x + off + 4); } } while (0)
#define ER_PROC(q) do { _Pragma("unroll") for (int ml = 0; ml < 2; ++ml) _Pragma("unroll") for (int bj = 0; bj < 2; ++bj) { const int ai = (q) >> 1, m = 2 * ((q) & 1) + ml; \
            const unsigned off = obase + (unsigned)((ai * HALF + m * 16) * DM + bj * HALF); \
            const f32x4 v0 = xs[(q) & 1][ml][bj][0] * ALPHA + acc[ai][bj][m][0], v1 = xs[(q) & 1][ml][bj][1] * ALPHA + acc[ai][bj][m][1]; \
            *(u32x4*)(rb + off) = pack8(v0, v1); } } while (0)
        ER_LOAD(0); ER_LOAD(1); ER_PROC(0); ER_LOAD(2); ER_PROC(1); ER_LOAD(3); ER_PROC(2); ER_PROC(3);
#undef ER_LOAD
#undef ER_PROC
    }
};
struct EpiPle {
    static constexpr bool PERM = true, AFTER_DRAIN = false, FUSED2 = false;
    bf16_t* ple;
    __device__ __forceinline__ void operator()(const f32x4 (&acc)[2][2][4][2], const Unit& u, int wr, int wc, int fr, int fq) const {
        const int row0 = u.pm * BM + wr * 64 + fr, col0 = u.pn * BM + wc * 32 + 8 * fq;
        const unsigned obase = (unsigned)row0 * DM + (unsigned)col0;
        u32x4 ev[2][2][2];
#define EP_LOAD(q) do { _Pragma("unroll") for (int ml = 0; ml < 2; ++ml) _Pragma("unroll") for (int bj = 0; bj < 2; ++bj) { const int ai = (q) >> 1, m = 2 * ((q) & 1) + ml; \
            ev[(q) & 1][ml][bj] = *(const u32x4*)(ple + (obase + (unsigned)((ai * HALF + m * 16) * DM + bj * HALF))); } } while (0)
#define EP_PROC(q) do { _Pragma("unroll") for (int ml = 0; ml < 2; ++ml) _Pragma("unroll") for (int bj = 0; bj < 2; ++bj) { const int ai = (q) >> 1, m = 2 * ((q) & 1) + ml; \
            f32x4 e0, e1; unpack8(ev[(q) & 1][ml][bj], e0, e1); \
            *(u32x4*)(ple + (obase + (unsigned)((ai * HALF + m * 16) * DM + bj * HALF))) = pack8(sig4(acc[ai][bj][m][0]) * e0, sig4(acc[ai][bj][m][1]) * e1); } } while (0)
        EP_LOAD(0); EP_LOAD(1); EP_PROC(0); EP_LOAD(2); EP_PROC(1); EP_LOAD(3); EP_PROC(2); EP_PROC(3);
#undef EP_LOAD
#undef EP_PROC
    }
};

template <int CTRL> __device__ __forceinline__ float dppf(float v) { return __builtin_bit_cast(float, __builtin_amdgcn_update_dpp(0, __builtin_bit_cast(int, v), CTRL, 0xf, 0xf, true)); }
__device__ __forceinline__ float row16_sum(float v) { v += dppf<0xB1>(v); v += dppf<0x4E>(v); v += dppf<0x141>(v); v += dppf<0x140>(v); return v; }
__device__ __forceinline__ void swap16(float v, float& a, float& b) { a = v; b = v; asm volatile("s_nop 1\n\tv_permlane16_swap_b32 %0, %1\n\ts_nop 1" : "+v"(a), "+v"(b)); }
__device__ __forceinline__ void swap32(float v, float& a, float& b) { a = v; b = v; asm volatile("s_nop 1\n\tv_permlane32_swap_b32 %0, %1\n\ts_nop 1" : "+v"(a), "+v"(b)); }
__device__ __forceinline__ float xor16_sum(float v) { float a, b; swap16(v, a, b); return a + b; }
__device__ __forceinline__ float xor32_sum(float v) { float a, b; swap32(v, a, b); return a + b; }
__device__ __forceinline__ float xor32_max(float v) { float a, b; swap32(v, a, b); return __builtin_fmaxf(a, b); }
__device__ __forceinline__ float wave_sum(float v) { return xor32_sum(xor16_sum(row16_sum(v))); }
__device__ __forceinline__ void transpose_item(const float* W, int K, int N, bf16_t* WT, int k0, int n_src, int n_dst, LAS float* scr, int lane) {
#pragma unroll 8
    for (int i = 0; i < 32; ++i) { const int kk = 2 * i + (lane >> 5); scr[kk * 33 + (lane & 31)] = W[(size_t)(k0 + kk) * N + n_src + (lane & 31)]; }
    asm volatile("s_waitcnt lgkmcnt(0)" ::: "memory");
    const int c = lane & 7;
#pragma unroll
    for (int j = 0; j < 4; ++j) { const int n = (lane >> 3) + 8 * j; const LAS float* s = scr + (8 * c) * 33 + n;
        u32x4 o; o.x = pk2(s[0 * 33], s[1 * 33]); o.y = pk2(s[2 * 33], s[3 * 33]); o.z = pk2(s[4 * 33], s[5 * 33]); o.w = pk2(s[6 * 33], s[7 * 33]);
        *(u32x4*)(WT + (size_t)(n_dst + n) * K + k0 + 8 * c) = o; }
    asm volatile("s_waitcnt lgkmcnt(0)" ::: "memory");
}
__device__ __forceinline__ int win_colmap(int np) {
    if (np < 4096) { const int tile = np >> 8, half = (np >> 7) & 1, c = np & 127, which = c >> 6, ch = 64 * tile + (c & 63);
        const int base = half == 0 ? (which == 0 ? 0 : 2048) : (which == 0 ? 1024 : 3072); return base + ch; }
    if (np < 6144) return np;
    if (np < NMAIN) return np + 1024;
    return 6144 + (np - NMAIN);
}
__device__ __forceinline__ void cvt_rows(const float* src, bf16_t* dst, size_t n8, int gtid, int gthreads) {
    for (size_t i = gtid; i < n8; i += gthreads) {
        const f32x4 a = *(const f32x4*)(src + i * 8), b = *(const f32x4*)(src + i * 8 + 4);
        *(u32x4*)(dst + i * 8) = pack8(a, b);
    }
}

__device__ __forceinline__ int crow(int r, int hi) { return (r & 3) + 8 * (r >> 2) + 4 * hi; }
__device__ __forceinline__ float max3f(float a, float b, float c) { float r; asm("v_max3_f32 %0, %1, %2, %3" : "=v"(r) : "v"(a), "v"(b), "v"(c)); return r; }
constexpr int KSLOT = 16384, VSLOT = 16384, ATT_K = 0, ATT_V = 3 * KSLOT, ATT_X = 0, ATT_WS = 131072;
__device__ __forceinline__ void glds16(const void* g, LAS unsigned char* l) { __builtin_amdgcn_global_load_lds((const unsigned*)g, (LAS unsigned*)l, 16, 0, 0); }

__device__ __forceinline__ void attn_unit(LAS unsigned char* lds, const bf16_t* __restrict__ q, const bf16_t* __restrict__ k, const bf16_t* __restrict__ vT,
                                          const bf16_t* __restrict__ szb, bf16_t* __restrict__ o_out, const float* __restrict__ subln_g, float lam, int b, int h, int qb, int wave_s) {
    int tid_ = fresh_tid(wave_s);
    const int tid = tid_, lane = tid & 63, r32 = lane & 31, hi = lane >> 5; const int wid = __builtin_amdgcn_readfirstlane(tid >> 6);
    const int mp = wid >> 2, wq = wid & 3;
    const float m2 = __builtin_amdgcn_exp2f(-(float)(h + 1)) * LOG2E;
    LAS float* wsf = (LAS float*)(lds + ATT_WS) + wid * 64;
    const int T0 = qb * 128 + wq * 32, tpos = T0 + r32;
    const int krow = (r32 & 0x13) | ((r32 & 4) << 1) | ((r32 & 8) >> 1);
    const int kr = 8 * wid + (lane >> 3);
    const unsigned kgo = (unsigned)((b * 8 + h) * 2 * 32 * 4096 + kr * 64 + (((lane & 7) ^ ((kr >> 1) & 7)) * 8));
    const unsigned vgo = (unsigned)((b * 8 + h) * 32 * 8192 + kr * 64 + (((lane & 7) ^ ((kr >> 1) & 7)) * 8));
    LAS unsigned char* kdst = lds + ATT_K + wid * 1024;
    LAS unsigned char* vdst = lds + ATT_V + wid * 1024;
#define DMA_K(tile, slot) do { const unsigned o_ = kgo + (unsigned)(tile) * 4096; glds16(k + o_, kdst + (slot) * KSLOT); glds16(k + o_ + 32 * 4096, kdst + (slot) * KSLOT + 8192); } while (0)
#define DMA_V(tile, slot) do { const unsigned o_ = vgo + (unsigned)(tile) * 8192; glds16(vT + o_, vdst + (slot) * VSLOT); glds16(vT + o_ + 4096, vdst + (slot) * VSLOT + 8192); } while (0)
#define TILE(j) ((2 * qb + (j)) & 31)
    int koffs[4], voffs[4];
    { const int fk = (krow >> 1) & 7, fv = (r32 >> 1) & 7;
#pragma unroll
      for (int i = 0; i < 4; ++i) { koffs[i] = mp * 8192 + krow * 128 + (((2 * i + hi) ^ fk) << 4); voffs[i] = r32 * 128 + (((2 * i + hi) ^ fv) << 4); } }
    const unsigned m2hi = f2bf(m2), m2lo = f2bf(m2 - __builtin_bit_cast(float, m2hi << 16));
    u32x4 kx0w = {0u, 0u, 0u, 0u}, kx1w = {0u, 0u, 0u, 0u}, qxw = {0u, 0u, 0u, 0u};
    if (hi == 0) {
        const unsigned s0 = f2bf((float)krow), s1 = f2bf((float)(krow + 32)), tr = f2bf((float)r32);
        kx0w.x = (m2hi | (m2lo << 16)) ^ 0x80008000u; kx0w.y = s0 | (s0 << 16);
        kx1w.x = kx0w.x; kx1w.y = s1 | (s1 << 16);
        qxw.x = tr | (tr << 16); qxw.y = m2hi | (m2lo << 16);
    }
    const bf16x8 kx0 = __builtin_bit_cast(bf16x8, kx0w), kx1 = __builtin_bit_cast(bf16x8, kx1w);

    asm volatile("s_waitcnt lgkmcnt(0)\n\ts_barrier" ::: "memory");
    bf16x8 qr[4];
    {
        const bf16_t* qp = q + (size_t)(b * SEQ + tpos) * DM + h * 128 + mp * 64 + hi * 8;
#pragma unroll
        for (int d0 = 0; d0 < 4; ++d0) qr[d0] = *(const bf16x8*)(qp + 16 * d0);
    }
    DMA_K(TILE(0), 0); DMA_K(TILE(1), 1); DMA_V(TILE(0), 0); DMA_K(TILE(2), 2); DMA_V(TILE(1), 1);
    f32x16 o[4];
#pragma unroll
    for (int d0 = 0; d0 < 4; ++d0)
#pragma unroll
        for (int r = 0; r < 16; ++r) o[d0][r] = 0.f;
    float mref = -1e30f, l = 0.f;
    float cstA = 0.f, cstB = 0.f; bool diagA = false, diagB = false;
    f32x16 A0, A1, B0, B1;
    const f32x16 zero16 = {0.f, 0.f, 0.f, 0.f, 0.f, 0.f, 0.f, 0.f, 0.f, 0.f, 0.f, 0.f, 0.f, 0.f, 0.f, 0.f};
#define ATT_SIDE(QX, CST, DIAG, jn) do { \
        const int S0_ = 64 * TILE(jn); u32x4 qs_ = qxw; \
        if (S0_ + 63 <= T0) { CST = -m2 * (float)(T0 - S0_); DIAG = false; } \
        else if (S0_ >= T0 + 31) { CST = -m2 * (float)(S0_ - T0); DIAG = false; qs_.x ^= 0x80008000u; qs_.y ^= 0x80008000u; } \
        else { CST = 0.f; DIAG = true; qs_.x = 0u; qs_.y = 0u; } \
        QX = __builtin_bit_cast(bf16x8, qs_); } while (0)
#define ATT_KREAD(KF, jn) do { const LAS unsigned char* kb_ = lds + ATT_K + ((jn) % 3) * KSLOT; \
        _Pragma("unroll") for (int d0 = 0; d0 < 4; ++d0) { KF[2 * d0] = *(const LAS bf16x8*)(kb_ + koffs[d0]); KF[2 * d0 + 1] = *(const LAS bf16x8*)(kb_ + koffs[d0] + 4096); } } while (0)
#define ATT_QKM(N0, N1, KF, QX) do { \
        N0 = __builtin_amdgcn_mfma_f32_32x32x16_bf16(kx0, QX, zero16, 0, 0, 0); N1 = __builtin_amdgcn_mfma_f32_32x32x16_bf16(kx1, QX, zero16, 0, 0, 0); \
        _Pragma("unroll") for (int d0 = 0; d0 < 4; ++d0) { \
            N0 = __builtin_amdgcn_mfma_f32_32x32x16_bf16(KF[2 * d0], qr[d0], N0, 0, 0, 0); N1 = __builtin_amdgcn_mfma_f32_32x32x16_bf16(KF[2 * d0 + 1], qr[d0], N1, 0, 0, 0); } } while (0)
#define ATT_ROWMAX(RM, X0, X1) do { float a_ = max3f(X0[0], X0[1], X1[0]), b_ = max3f(X0[2], X0[3], X1[1]); a_ = max3f(a_, X1[2], X1[3]); \
        _Pragma("unroll") for (int r = 4; r < 16; r += 4) { a_ = max3f(a_, X0[r], X0[r + 1]); b_ = max3f(b_, X0[r + 2], X0[r + 3]); a_ = max3f(a_, X1[r], X1[r + 1]); b_ = max3f(b_, X1[r + 2], X1[r + 3]); } \
        RM = max3f(a_, b_, b_); } while (0)
#define SB_ __builtin_amdgcn_sched_barrier(0)
#define EXPCH(X, base, n) do { _Pragma("unroll") for (int r = (base); r < (base) + (n); ++r) X[r] = __builtin_amdgcn_exp2f(X[r] - sub_); } while (0)
#define PACK4(k, X, base) do { w_.x = pk2(X[(base)], X[(base) + 1]); w_.y = pk2(X[(base) + 2], X[(base) + 3]); w_.z = pk2(X[(base) + 4], X[(base) + 5]); w_.w = pk2(X[(base) + 6], X[(base) + 7]); pa_[k] = __builtin_bit_cast(bf16x8, w_); } while (0)
#define VREAD(VF, ks) do { _Pragma("unroll") for (int d0 = 0; d0 < 4; ++d0) VF[d0] = *(const LAS bf16x8*)(vb_ + voffs[ks] + d0 * 4096); } while (0)
#define PVG(ks, VF, d0, SUMST, MAXST) do { o[d0] = __builtin_amdgcn_mfma_f32_32x32x16_bf16(pa_[ks], VF[d0], o[d0], 0, 0, 0); SUMST; MAXST; SB_; } while (0)
#define ATT_STEP(C0, C1, CCST, CDIAG, RMC, N0, N1, NCST, NDIAG, RMN, j, HN) do { \
        if (CDIAG) { const float dts_ = (float)(tpos - 64 * TILE(j) - 8 * hi); \
            _Pragma("unroll") for (int r = 0; r < 16; ++r) { const float c_ = (float)(16 * (r >> 3) + (r & 7)); \
                C0[r] = __builtin_fmaf(-m2, __builtin_fabsf(dts_ - c_), C0[r]); C1[r] = __builtin_fmaf(-m2, __builtin_fabsf(dts_ - (c_ + 32.f)), C1[r]); } \
            float rm2_; ATT_ROWMAX(rm2_, C0, C1); RMC = xor32_max(rm2_); } \
        if (__any(RMC > mref + 8.0f)) { \
            const float mnew_ = __builtin_fmaxf(mref, RMC); const float f_ = __builtin_amdgcn_exp2f(mref - mnew_); \
            l *= f_; mref = mnew_; \
            if (hi == 0) wsf[r32] = f_; \
            asm volatile("s_waitcnt lgkmcnt(0)" ::: "memory"); \
            _Pragma("unroll") for (int r = 0; r < 16; ++r) { const float fr_ = wsf[crow(r, hi)]; \
                _Pragma("unroll") for (int d0 = 0; d0 < 4; ++d0) o[d0][r] *= fr_; } } \
        const bool skip_ = __all(RMC < mref - 150.0f);     \
        const float sub_ = mref - CCST; \
        bf16x8 kf_[8]; bf16x8 qx_ = qr[0]; \
        if (HN) { ATT_SIDE(qx_, NCST, NDIAG, (j) + 1); ATT_KREAD(kf_, (j) + 1); asm volatile("" ::: "memory"); } \
        if ((j) + 3 < 32) { DMA_K(TILE((j) + 3), (j) % 3); } \
        if (HN) { ATT_QKM(N0, N1, kf_, qx_); } \
        if ((j) < 29) asm volatile("s_waitcnt vmcnt(4) lgkmcnt(0)\n\ts_barrier" ::: "memory"); \
        else asm volatile("s_waitcnt vmcnt(0) lgkmcnt(0)\n\ts_barrier" ::: "memory"); \
        __builtin_amdgcn_s_setprio(1); \
        if ((j) + 2 < 32) { DMA_V(TILE((j) + 2), ((j) + 2) % 3); } \
        if (!skip_) { const LAS unsigned char* vb_ = lds + ATT_V + ((j) % 3) * VSLOT; \
          bf16x8 vfa_[4], vfb_[4]; bf16x8 pa_[4]; u32x4 w_; float ls_ = 0.f; \
          VREAD(vfa_, 0); VREAD(vfb_, 1); asm volatile("" ::: "memory"); SB_; \
          EXPCH(C0, 0, 8); PACK4(0, C0, 0); SB_; \
          PVG(0, vfa_, 0, EXPCH(C0, 8, 2), (void)0); \
          PVG(0, vfa_, 1, EXPCH(C0, 10, 2), (void)0); \
          PVG(0, vfa_, 2, EXPCH(C0, 12, 2), (void)0); \
          PVG(0, vfa_, 3, EXPCH(C0, 14, 2), (void)0); \
          VREAD(vfa_, 2); asm volatile("" ::: "memory"); PACK4(1, C0, 8); SB_; \
          PVG(1, vfb_, 0, EXPCH(C1, 0, 2), ls_ += C0[0] + C0[1]); \
          PVG(1, vfb_, 1, EXPCH(C1, 2, 2), ls_ += C0[2] + C0[3]); \
          PVG(1, vfb_, 2, EXPCH(C1, 4, 2), ls_ += C0[4] + C0[5]); \
          PVG(1, vfb_, 3, EXPCH(C1, 6, 2), ls_ += C0[6] + C0[7]); \
          VREAD(vfb_, 3); asm volatile("" ::: "memory"); PACK4(2, C1, 0); SB_; \
          PVG(2, vfa_, 0, EXPCH(C1, 8, 2), ls_ += C0[8] + C0[9]); \
          PVG(2, vfa_, 1, EXPCH(C1, 10, 2), ls_ += C0[10] + C0[11]); \
          PVG(2, vfa_, 2, EXPCH(C1, 12, 2), ls_ += C0[12] + C0[13]); \
          PVG(2, vfa_, 3, EXPCH(C1, 14, 2), ls_ += C0[14] + C0[15]); \
          PACK4(3, C1, 8); SB_; \
          PVG(3, vfb_, 0, ls_ += (C1[0] + C1[1]) + (C1[2] + C1[3]), (void)0); \
          PVG(3, vfb_, 1, ls_ += (C1[4] + C1[5]) + (C1[6] + C1[7]), (void)0); \
          PVG(3, vfb_, 2, ls_ += (C1[8] + C1[9]) + (C1[10] + C1[11]), (void)0); \
          PVG(3, vfb_, 3, ls_ += (C1[12] + C1[13]) + (C1[14] + C1[15]), (void)0); \
          l += ls_; } \
        if (HN) { float rmn_; ATT_ROWMAX(rmn_, N0, N1); RMN = xor32_max(rmn_) + NCST; } \
        __builtin_amdgcn_s_setprio(0); \
        if ((j) < 29) asm volatile("s_waitcnt vmcnt(4) lgkmcnt(0)\n\ts_barrier" ::: "memory"); \
        else asm volatile("s_waitcnt vmcnt(0) lgkmcnt(0)\n\ts_barrier" ::: "memory"); \
    } while (0)

    asm volatile("s_waitcnt vmcnt(4)\n\ts_barrier" ::: "memory");
    float rmA = 0.f, rmB = 0.f;
    { bf16x8 kf0_[8]; bf16x8 qx0_; ATT_SIDE(qx0_, cstA, diagA, 0); ATT_KREAD(kf0_, 0); ATT_QKM(A0, A1, kf0_, qx0_);
      float rm_; ATT_ROWMAX(rm_, A0, A1); rmA = xor32_max(rm_) + cstA; }
    asm volatile("s_waitcnt lgkmcnt(0)\n\ts_barrier" ::: "memory");
    if (mp == 1) asm volatile("s_barrier" ::: "memory");
#pragma unroll 1
    for (int jj = 0; jj < 30; jj += 2) {
        ATT_STEP(A0, A1, cstA, diagA, rmA, B0, B1, cstB, diagB, rmB, jj, 1);
        ATT_STEP(B0, B1, cstB, diagB, rmB, A0, A1, cstA, diagA, rmA, jj + 1, 1);
    }
    ATT_STEP(A0, A1, cstA, diagA, rmA, B0, B1, cstB, diagB, rmB, 30, 1);
    ATT_STEP(B0, B1, cstB, diagB, rmB, A0, A1, cstA, diagA, rmA, 31, 0);
    if (mp == 0) asm volatile("s_barrier" ::: "memory");
#undef ATT_STEP
#undef SB_
#undef EXPCH
#undef PACK4
#undef VREAD
#undef PVG
#undef ATT_QKM
#undef ATT_KREAD
#undef ATT_SIDE
#undef ATT_ROWMAX
#undef DMA_K
#undef DMA_V
#undef TILE
    const int fr_row = 16 * mp + (lane >> 4), fr_col = 4 * (lane & 15);
    u32x2 zA[4], zB[4];
    {
        const bf16_t* zp = szb + (size_t)(b * SEQ + T0 + fr_row) * DM + h * 128 + fr_col;
#pragma unroll
        for (int i = 0; i < 4; ++i) { zA[i] = *(const u32x2*)(zp + (size_t)(4 * i) * DM); zB[i] = *(const u32x2*)(zp + (size_t)(4 * i) * DM + 64); }
    }
    l = xor32_sum(l);
    if (hi == 0) wsf[32 + r32] = l;
    asm volatile("s_waitcnt lgkmcnt(0)" ::: "memory");
    LAS float* xch = (LAS float*)(lds + ATT_X) + wid * 4096;
    const float msc = mp == 0 ? 1.0f : -lam;
#pragma unroll
    for (int r = 0; r < 16; ++r) {
        const float rl = __builtin_amdgcn_rcpf(wsf[32 + crow(r, hi)]) * msc;
#pragma unroll
        for (int d0 = 0; d0 < 4; ++d0) xch[crow(r, hi) * 128 + 32 * d0 + r32] = o[d0][r] * rl;
    }
    asm volatile("s_waitcnt lgkmcnt(0)\n\ts_barrier" ::: "memory");
    {
        const LAS float* xa = (const LAS float*)(lds + ATT_X) + wq * 4096, * xb_ = xa + 4 * 4096;
        bf16_t* op = o_out + (size_t)(b * SEQ + T0 + fr_row) * DM + h * 128 + fr_col;
        const f32x4 gA = *(const f32x4*)(subln_g + fr_col) * (1.0f - LAMBDA_INIT), gB = *(const f32x4*)(subln_g + 64 + fr_col) * (1.0f - LAMBDA_INIT);
#pragma unroll
        for (int i = 0; i < 4; ++i) {
            const int ro = (fr_row + 4 * i) * 128 + fr_col;
            const f32x4 ya = *(const LAS f32x4*)(xa + ro) + *(const LAS f32x4*)(xb_ + ro), yb = *(const LAS f32x4*)(xa + ro + 64) + *(const LAS f32x4*)(xb_ + ro + 64);
            float ss = (ya[0] * ya[0] + ya[1] * ya[1]) + (ya[2] * ya[2] + ya[3] * ya[3]) + (yb[0] * yb[0] + yb[1] * yb[1]) + (yb[2] * yb[2] + yb[3] * yb[3]);
            ss = row16_sum(ss);
            const float rs = __builtin_amdgcn_rsqf(ss * (1.0f / 128.0f) + RMS_EPS);
            const f32x4 za = (f32x4){bf_lo(zA[i].x), bf_hi(zA[i].x), bf_lo(zA[i].y), bf_hi(zA[i].y)}, zb = (f32x4){bf_lo(zB[i].x), bf_hi(zB[i].x), bf_lo(zB[i].y), bf_hi(zB[i].y)};
            const f32x4 va = ya * rs * gA * za, vb = yb * rs * gB * zb;
            u32x2 wa, wb; wa.x = pk2(va[0], va[1]); wa.y = pk2(va[2], va[3]); wb.x = pk2(vb[0], vb[1]); wb.y = pk2(vb[2], vb[3]);
            *(u32x2*)(op + (size_t)(4 * i) * DM) = wa; *(u32x2*)(op + (size_t)(4 * i) * DM + 64) = wb;
        }
    }
}

__global__ void __launch_bounds__(512, 2) fwd_mega(Args a) {
    extern __shared__ __attribute__((aligned(16))) unsigned char lds_raw[];
    LAS unsigned char* lds = (LAS unsigned char*)lds_raw;
    cg::grid_group grid = cg::this_grid();
    const int G = gridDim.x, bx = blockIdx.x;
    const int wave_s = __builtin_amdgcn_readfirstlane((int)(threadIdx.x >> 6));
#define FRESH_TID() const int tid_l = fresh_tid(wave_s); const int tid = tid_l, lane = tid & 63; const int wave = __builtin_amdgcn_readfirstlane(tid >> 6); (void)lane; (void)wave
    const int vcu = (G % 8 == 0) ? (bx % 8) * (G / 8) + bx / 8 : bx;
    unsigned char* ws = a.ws;
    bf16_t* Wt = (bf16_t*)(ws + WS_WIN); bf16_t* Wa_t = (bf16_t*)(ws + WS_WA); bf16_t* Wb_t = (bf16_t*)(ws + WS_WB); bf16_t* Wo_t = (bf16_t*)(ws + WS_WOUT);
    bf16_t* Wg_t = (bf16_t*)(ws + WS_WG); bf16_t* Wp_t = (bf16_t*)(ws + WS_WPLE); bf16_t* pb = (bf16_t*)(ws + WS_PB);
    bf16_t* xb = (bf16_t*)(ws + WS_XB); bf16_t* obuf = xb;
    bf16_t* hcu = (bf16_t*)(ws + WS_HCU);
    bf16_t* gap = (bf16_t*)(ws + WS_GAP); bf16_t* rb = gap;
    bf16_t* qbuf = (bf16_t*)(ws + WS_Q); float* rbuf = (float*)(ws + WS_Q); bf16_t* merged = qbuf;
    bf16_t* kbuf = (bf16_t*)(ws + WS_K);
    bf16_t* vT = (bf16_t*)(ws + WS_VT);
    bf16_t* szb = (bf16_t*)(ws + WS_SZB); bf16_t* ple = szb;
    bf16_t* sga = (bf16_t*)a.out; bf16_t* sgb = sga + (size_t)TOK * DM;

    {
        FRESH_TID();
        const int gthreads = G * 512, gtid = vcu * 512 + tid;
        cvt_rows(a.x, xb, (size_t)TOK * DM / 8, gtid, gthreads);
        cvt_rows(a.p, pb, (size_t)TOK * PLE / 8, gtid, gthreads);
        LAS float* scr = (LAS float*)(lds + wave * 16384);
        const int gw = vcu * 8 + wave, NGW = G * 8;
        constexpr int I_IN = 16 * 320, I_SQ = 16 * 32, I_PLE = 4 * 32, NITEMS = I_IN + 4 * I_SQ + I_PLE;
        for (int it = gw; it < NITEMS; it += NGW) {
            int r = it;
            if (r < I_IN) { const int kb = r / 320, nb = r % 320; transpose_item(a.w_in, 1024, 10240, Wt, 64 * kb, win_colmap(32 * nb), 32 * nb, scr, lane); continue; } r -= I_IN;
            if (r < 4 * I_SQ) { const int w = r / I_SQ, rr = r % I_SQ, kb = rr / 32, nb = rr % 32;
                const float* src = w == 0 ? a.w_proj_a : w == 1 ? a.w_proj_b : w == 2 ? a.w_out : a.w_ple_gate;
                bf16_t* dst = w == 0 ? Wa_t : w == 1 ? Wb_t : w == 2 ? Wo_t : Wg_t;
                transpose_item(src, 1024, 1024, dst, 64 * kb, 32 * nb, 32 * nb, scr, lane); continue; } r -= 4 * I_SQ;
            { const int kb = r / 32, nb = r % 32; transpose_item(a.w_ple, 256, 1024, Wp_t, 64 * kb, 32 * nb, 32 * nb, scr, lane); }
        }
    }
    grid.sync();

#ifndef P1_REP
#define P1_REP 1
#endif
#pragma unroll 1
    for (int rep1 = 0; rep1 < P1_REP; ++rep1) {
#if !defined(ONLY_G) || ONLY_G == 1
    {
        Gemm g{xb, Wt, TOK, NMAIN, DM, nullptr, nullptr}; StaticOrder S; S.init(TOK, NMAIN, G, bx);
        EpiProj E{hcu, gap, qbuf, kbuf, szb, sga, sgb};
        gemm_phase<EpiProj, StaticOrder, true, true>(lds, g, S, E, wave_s);
    }
#endif
#if !defined(ONLY_G) || ONLY_G == 2
    {
        Gemm g{Wt + (size_t)NMAIN * DM, xb, 1024, TOK, DM, nullptr, nullptr}; StaticOrder S; S.init(1024, TOK, G, bx);
        EpiVT E{vT};
        gemm_phase<EpiVT, StaticOrder, true, true>(lds, g, S, E, wave_s);
    }
#endif
    }
    grid.sync();

#define PANEL_SEAM() do { asm volatile("s_waitcnt vmcnt(0)" ::: "memory"); __syncthreads(); __builtin_amdgcn_fence(__ATOMIC_ACQUIRE, "agent"); } while (0)
    float lam;
    { FRESH_TID();
      const float s1 = wave_sum(a.lq1[lane] * a.lk1[lane]), s2 = wave_sum(a.lq2[lane] * a.lk2[lane]);
      lam = __builtin_bit_cast(float, __builtin_amdgcn_readfirstlane(__builtin_bit_cast(int, __expf(s1) - __expf(s2) + LAMBDA_INIT))); }
#pragma unroll 1
    for (int panel = vcu; panel < TOK / BM; panel += G) {
        {
            FRESH_TID();
            const int t0 = panel * BM;
            for (int i = tid; i < (BM / 2) * (DM / 8); i += 512) {
                const int t = t0 + 2 * (i >> 7), c8 = (i & 127) * 8, s = t & (SEQ - 1);
                const size_t off = (size_t)t * DM + c8;
                const u32x4 z4 = {0u, 0u, 0u, 0u};
                const u32x4 r1 = *(const u32x4*)(hcu + off), r2 = *(const u32x4*)(hcu + off + DM);
                const u32x4 r0 = s > 0 ? *(const u32x4*)(hcu + off - DM) : z4, r3 = s + 2 < SEQ ? *(const u32x4*)(hcu + off + 2 * DM) : z4;
                const u32x4 g0r = *(const u32x4*)(gap + off), g1r = *(const u32x4*)(gap + off + DM);
                f32x4 h0a, h0b, h1a, h1b, h2a, h2b, h3a, h3b, ga, gb, gc, gd;
                unpack8(r0, h0a, h0b); unpack8(r1, h1a, h1b); unpack8(r2, h2a, h2b); unpack8(r3, h3a, h3b); unpack8(g0r, ga, gb); unpack8(g1r, gc, gd);
                const f32x4 w0a = *(const f32x4*)(a.conv_w + c8), w0b = *(const f32x4*)(a.conv_w + c8 + 4);
                const f32x4 w1a = *(const f32x4*)(a.conv_w + DM + c8), w1b = *(const f32x4*)(a.conv_w + DM + c8 + 4);
                const f32x4 w2a = *(const f32x4*)(a.conv_w + 2 * DM + c8), w2b = *(const f32x4*)(a.conv_w + 2 * DM + c8 + 4);
                const f32x4 cba = *(const f32x4*)(a.conv_b + c8), cbb = *(const f32x4*)(a.conv_b + c8 + 4);
                *(u32x4*)(gap + off) = pack8(ga * (w0a * h0a + w1a * h1a + w2a * h2a + cba), gb * (w0b * h0b + w1b * h1b + w2b * h2b + cbb));
                *(u32x4*)(gap + off + DM) = pack8(gc * (w0a * h1a + w1a * h2a + w2a * h3a + cba), gd * (w0b * h1b + w1b * h2b + w2b * h3b + cbb));
            }
        }
#pragma unroll 1
        for (int un = 0; un < 16; ++un)
            attn_unit(lds, qbuf, kbuf, vT, szb, obuf, a.subln_g, lam, panel >> 3, un >> 1, 2 * (panel & 7) + (un & 1), wave_s);
        PANEL_SEAM();
        const PanelOrder S4{panel, DM / BM};
        { Gemm g{gap, Wa_t, TOK, DM, DM, obuf, Wb_t}; const PanelOrder2 S2{panel, DM / BM}; EpiMerge E{sga, merged}; gemm_phase<EpiMerge, PanelOrder2, true, true>(lds, g, S2, E, wave_s); }
        PANEL_SEAM();
        { Gemm g{merged, Wo_t, TOK, DM, DM, nullptr, nullptr}; EpiRes E{a.x, rbuf, rb}; gemm_phase<EpiRes, PanelOrder, true, true>(lds, g, S4, E, wave_s); }
        { Gemm g{pb, Wp_t, TOK, DM, PLE, nullptr, nullptr}; EpiStore E{ple}; gemm_phase<EpiStore, PanelOrder, true, true>(lds, g, S4, E, wave_s); }
        PANEL_SEAM();
        { Gemm g{rb, Wg_t, TOK, DM, DM, nullptr, nullptr}; EpiPle E{ple}; gemm_phase<EpiPle, PanelOrder, true, true>(lds, g, S4, E, wave_s); }
        PANEL_SEAM();
        {
            FRESH_TID();
            f32x4 gg[4], bb[4];
#pragma unroll
            for (int j = 0; j < 4; ++j) { gg[j] = *((const f32x4*)a.ln_g + lane + 64 * j); bb[j] = *((const f32x4*)a.ln_b + lane + 64 * j); }
#pragma unroll 1
            for (int rr = wave; rr < BM; rr += 8) {
                const int m = panel * BM + rr;
                const u32x2* xr = (const u32x2*)(rb + (size_t)m * DM) + lane; const u32x2* dr = (const u32x2*)(ple + (size_t)m * DM) + lane;
                f32x4 v[4]; float s_ = 0.f;
#pragma unroll
                for (int j = 0; j < 4; ++j) { const u32x2 a_ = xr[64 * j], d_ = dr[64 * j];
                    v[j] = (f32x4){bf_lo(a_.x) + bf_lo(d_.x), bf_hi(a_.x) + bf_hi(d_.x), bf_lo(a_.y) + bf_lo(d_.y), bf_hi(a_.y) + bf_hi(d_.y)}; s_ += (v[j].x + v[j].y) + (v[j].z + v[j].w); }
                const float mean = wave_sum(s_) * (1.f / DM); float s2 = 0.f;
#pragma unroll
                for (int j = 0; j < 4; ++j) { v[j] = v[j] - mean; s2 += (v[j].x * v[j].x + v[j].y * v[j].y) + (v[j].z * v[j].z + v[j].w * v[j].w); }
                const float rstd = __builtin_amdgcn_rsqf(wave_sum(s2) * (1.f / DM) + LN_EPS);
                f32x4* orow = (f32x4*)(a.out + (size_t)m * DM) + lane;
#pragma unroll
                for (int j = 0; j < 4; ++j) orow[64 * j] = v[j] * rstd * gg[j] + bb[j];
            }
        }
        PANEL_SEAM();
    }
#undef PANEL_SEAM
}

extern "C" void kernel_launch(void* const* d_in, const int* in_sizes, int n_in, void* d_out, int out_size, void* d_ws, size_t ws_size, hipStream_t stream) {
    static int grid = 0;
    if (grid == 0) {
        if (n_in != 17 || in_sizes[0] != TOK * DM || out_size != TOK * DM || ws_size < WS_END) { fprintf(stderr, "kernel_launch: unexpected shapes (n_in %d, in0 %d, out %d, ws %zu)\n", n_in, n_in > 0 ? in_sizes[0] : -1, out_size, ws_size); grid = -1; return; }
        int dev = 0, cus = 0, per_cu = 0;
        (void)hipGetDevice(&dev); (void)hipDeviceGetAttribute(&cus, hipDeviceAttributeMultiprocessorCount, dev);
        if (hipFuncSetAttribute((const void*)fwd_mega, hipFuncAttributeMaxDynamicSharedMemorySize, LDS_BYTES) != hipSuccess) { fprintf(stderr, "kernel_launch: hipFuncSetAttribute failed\n"); grid = -1; return; }
        if (hipOccupancyMaxActiveBlocksPerMultiprocessor(&per_cu, (const void*)fwd_mega, 512, LDS_BYTES) != hipSuccess || per_cu < 1) { fprintf(stderr, "kernel_launch: occupancy query says %d\n", per_cu); per_cu = 1; }
        (void)hipGetLastError();
        grid = cus * per_cu;
    }
    if (grid < 0) return;
    Args a{};
    a.x = (const float*)d_in[0]; a.p = (const float*)d_in[1]; a.w_in = (const float*)d_in[2]; a.conv_w = (const float*)d_in[3]; a.conv_b = (const float*)d_in[4];
    a.w_proj_a = (const float*)d_in[5]; a.lq1 = (const float*)d_in[6]; a.lk1 = (const float*)d_in[7]; a.lq2 = (const float*)d_in[8]; a.lk2 = (const float*)d_in[9];
    a.subln_g = (const float*)d_in[10]; a.w_proj_b = (const float*)d_in[11]; a.w_out = (const float*)d_in[12]; a.w_ple = (const float*)d_in[13]; a.w_ple_gate = (const float*)d_in[14];
    a.ln_g = (const float*)d_in[15]; a.ln_b = (const float*)d_in[16];
    a.out = (float*)d_out; a.ws = (unsigned char*)d_ws;
    void* args[] = {&a};
    hipError_t e = hipLaunchCooperativeKernel((const void*)fwd_mega, dim3(grid), dim3(512), args, LDS_BYTES, stream);
    if (e != hipSuccess) fprintf(stderr, "kernel_launch: cooperative launch failed: %s (grid %d)\n", hipGetErrorString(e), grid);
}
```
